# Optimizing an MI355X kernel written in HIP

```python
import math
import jax, jax.numpy as jnp
from jax import lax
import numpy as np

D_MODEL = 1024
BATCH = 2
SEQ = 8192
DEPTH = 2

N_META = 16
CHUNK = 16
Q_BLOCK = 128
BRANCH_WIDTH = D_MODEL // 2
HGRN_HEADS = 4
HGRN_EXPAND = 128
HGRN_FDIM = HGRN_HEADS * HGRN_EXPAND
HGRN_DV = BRANCH_WIDTH // HGRN_HEADS
GLA_HEADS = 4
GLA_DK = 64
GLA_DV = BRANCH_WIDTH // GLA_HEADS
GLA_GATE_RANK = 16
GLA_GATE_NORMALIZER = 16.0
DIFF_HEADS = 4
DIFF_DH = 64
DIFF_DV = BRANCH_WIDTH // DIFF_HEADS
N_BRANCH = 3
D_FF = 2816
CONV_WIDTH = 3
EPS = 1e-6
MASK_VALUE = -1e30

IN_SPLITS = (HGRN_FDIM, HGRN_FDIM, BRANCH_WIDTH, BRANCH_WIDTH,
             GLA_HEADS * GLA_DK, GLA_HEADS * GLA_DK, BRANCH_WIDTH, BRANCH_WIDTH, GLA_GATE_RANK,
             DIFF_HEADS * 2 * DIFF_DH, DIFF_HEADS * 2 * DIFF_DH, BRANCH_WIDTH,
             D_MODEL, D_MODEL, D_MODEL)
D_IN = sum(IN_SPLITS)

kernel_name = "hybrid_hgrn2_gla_diffattn_convffn"


def rms_norm(x, w):
    xf = x.astype(jnp.float32)
    y = xf * lax.rsqrt(jnp.mean(xf * xf, axis=-1, keepdims=True) + EPS)
    return (y * w.astype(jnp.float32)).astype(x.dtype)


def to_heads(t, n_heads):
    b, l, _ = t.shape
    return t.reshape(b, l, n_heads, -1).transpose(0, 2, 1, 3)


def from_heads(t):
    b, h, l, d = t.shape
    return t.transpose(0, 2, 1, 3).reshape(b, l, h * d)


def chunk_gated_linear_recurrence(q, k, v, g):
    b, h, l, dk = q.shape
    dv = v.shape[-1]
    n = l // CHUNK
    qf = q.astype(jnp.float32).reshape(b, h, n, CHUNK, dk)
    kf = k.astype(jnp.float32).reshape(b, h, n, CHUNK, dk)
    vf = v.astype(jnp.float32).reshape(b, h, n, CHUNK, dv)
    gc = jnp.cumsum(g.astype(jnp.float32).reshape(b, h, n, CHUNK, dk), axis=3)
    ref = gc[:, :, :, CHUNK // 2 - 1:CHUNK // 2]
    a = jnp.einsum('bhnid,bhnjd->bhnij', qf * jnp.exp(gc - ref), kf * jnp.exp(ref - gc))
    causal = jnp.tril(jnp.ones((CHUNK, CHUNK), dtype=bool))
    o_intra = jnp.einsum('bhnij,bhnjv->bhniv', jnp.where(causal, a, 0.0), vf)
    g_last = gc[:, :, :, -1]
    q_s = qf * jnp.exp(gc)
    k_s = kf * jnp.exp(g_last[:, :, :, None] - gc)

    def step(state, inp):
        q_n, k_n, v_n, gl_n = inp
        o_n = jnp.einsum('bhid,bhdv->bhiv', q_n, state)
        state = jnp.exp(gl_n)[..., None] * state + jnp.einsum('bhjd,bhjv->bhdv', k_n, v_n)
        return state, o_n

    s0 = jnp.zeros((b, h, dk, dv), jnp.float32)
    xs = (jnp.moveaxis(q_s, 2, 0), jnp.moveaxis(k_s, 2, 0), jnp.moveaxis(vf, 2, 0), jnp.moveaxis(g_last, 2, 0))
    _, o_inter = lax.scan(step, s0, xs)
    o = o_intra + jnp.moveaxis(o_inter, 0, 2)
    return o.reshape(b, h, l, dv).astype(v.dtype)


def hgrn2_mixer(hq, hf, hi, hg, lower_bound, norm_w):
    b, l, _ = hq.shape
    q = jax.nn.silu(to_heads(hq, HGRN_HEADS))
    f = to_heads(hf, HGRN_HEADS).astype(jnp.float32)
    lb = lower_bound.astype(jnp.float32).reshape(HGRN_HEADS, 1, HGRN_EXPAND)
    forget = lb + (1.0 - lb) * jax.nn.sigmoid(f)
    k = (1.0 - forget).astype(hq.dtype)
    o = chunk_gated_linear_recurrence(q, k, to_heads(hi, HGRN_HEADS), jnp.log(forget))
    o = o.transpose(0, 2, 1, 3)
    gate = hg.reshape(b, l, HGRN_HEADS, HGRN_DV)
    o = rms_norm(o, norm_w) * jax.nn.silu(gate)
    return o.reshape(b, l, BRANCH_WIDTH)


def gla_mixer(gq, gk, gv, gg, g_lowrank, gate_up, gate_bias, norm_w):
    b, l, _ = gq.shape
    q = to_heads(gq, GLA_HEADS) * (GLA_DK ** -0.5)
    k = to_heads(gk, GLA_HEADS)
    v = to_heads(gv, GLA_HEADS)
    logit = (g_lowrank @ gate_up + gate_bias).astype(jnp.float32)
    g = to_heads(jax.nn.log_sigmoid(logit) / GLA_GATE_NORMALIZER, GLA_HEADS)
    o = chunk_gated_linear_recurrence(q, k, v, g).transpose(0, 2, 1, 3)
    gate = gg.reshape(b, l, GLA_HEADS, GLA_DV)
    o = rms_norm(o, norm_w) * jax.nn.silu(gate)
    return o.reshape(b, l, BRANCH_WIDTH)


def diff_attention_mixer(dq, dk, dv, lam, lambda_init, subln_w):
    b, l, _ = dq.shape
    q = dq.reshape(b, l, DIFF_HEADS, 2, DIFF_DH).transpose(0, 2, 3, 1, 4)
    k = dk.reshape(b, l, DIFF_HEADS, 2, DIFF_DH).transpose(0, 2, 3, 1, 4)
    v = to_heads(dv, DIFF_HEADS)
    slopes = 2.0 ** (-8.0 * jnp.arange(1, DIFF_HEADS + 1, dtype=jnp.float32) / DIFF_HEADS)
    k_pos = jnp.arange(l)
    scale = DIFF_DH ** -0.5

    def attend(q_blk, q_pos):
        dist = (q_pos[:, None] - k_pos[None, :]).astype(jnp.float32)
        s = jnp.einsum('bhmqd,bhmkd->bhmqk', q_blk, k, preferred_element_type=jnp.float32) * scale
        s = s - slopes[:, None, None, None] * dist
        s = jnp.where(dist >= 0, s, MASK_VALUE)
        p = jax.nn.softmax(s, axis=-1)
        p = p[:, :, 0] - lam * p[:, :, 1]
        return jnp.einsum('bhqk,bhkv->bhqv', p.astype(v.dtype), v)

    o_meta = attend(q[:, :, :, :N_META], jnp.arange(N_META))
    n_blk = (l - N_META) // Q_BLOCK
    q_real = q[:, :, :, N_META:].reshape(b, DIFF_HEADS, 2, n_blk, Q_BLOCK, DIFF_DH)
    q_real = jnp.moveaxis(q_real, 3, 0)
    pos_real = N_META + jnp.arange(n_blk * Q_BLOCK).reshape(n_blk, Q_BLOCK)
    o_real = lax.map(lambda xs: attend(xs[0], xs[1]), (q_real, pos_real))
    o_real = jnp.moveaxis(o_real, 0, 2).reshape(b, DIFF_HEADS, n_blk * Q_BLOCK, DIFF_DV)
    o = jnp.concatenate([o_meta, o_real], axis=2)
    o = rms_norm(o, subln_w) * (1.0 - lambda_init)
    return from_heads(o)


def conv_ffn(h, w_gate, w_up, conv_w, conv_b, w_down):
    l = h.shape[1]
    u = h @ w_gate
    up = jnp.pad(u, ((0, 0), (CONV_WIDTH - 1, 0), (0, 0)))
    c = conv_b
    for j in range(CONV_WIDTH):
        c = c + conv_w[j] * up[:, j:j + l]
    return (jax.nn.gelu(c) * (h @ w_up)) @ w_down


def setup_inputs(seed: int = 0) -> dict:
    key = jax.random.key(seed)
    ks = iter(jax.random.split(key, 32))

    def nrm(shape, scale):
        return jax.random.normal(next(ks), shape, jnp.float32) * scale

    def gain(shape):
        return 1.0 + nrm(shape, 0.01)

    return {
        "x": nrm((BATCH, SEQ, D_MODEL), 1.0),
        "meta_tokens": nrm((N_META, D_MODEL), 1.0),
        "hgrn_lower_bounds": nrm((DEPTH, HGRN_FDIM), 0.1),
        "norm_mix_pre": gain((DEPTH, D_MODEL)),
        "w_in": nrm((DEPTH, D_MODEL, D_IN), D_MODEL ** -0.5),
        "hgrn_norm_w": gain((DEPTH, HGRN_DV)),
        "gla_gate_up": nrm((DEPTH, GLA_GATE_RANK, GLA_HEADS * GLA_DK), GLA_GATE_RANK ** -0.5),
        "gla_gate_bias": nrm((DEPTH, GLA_HEADS * GLA_DK), 0.01),
        "gla_norm_w": gain((DEPTH, GLA_DV)),
        "diff_lambda_q1": nrm((DEPTH, DIFF_DH), 0.1),
        "diff_lambda_k1": nrm((DEPTH, DIFF_DH), 0.1),
        "diff_lambda_q2": nrm((DEPTH, DIFF_DH), 0.1),
        "diff_lambda_k2": nrm((DEPTH, DIFF_DH), 0.1),
        "diff_subln_w": gain((DEPTH, DIFF_DV)),
        "w_branch_hgrn": nrm((DEPTH, BRANCH_WIDTH, D_MODEL), BRANCH_WIDTH ** -0.5),
        "w_branch_gla": nrm((DEPTH, BRANCH_WIDTH, D_MODEL), BRANCH_WIDTH ** -0.5),
        "w_branch_diff": nrm((DEPTH, BRANCH_WIDTH, D_MODEL), BRANCH_WIDTH ** -0.5),
        "w_out": nrm((DEPTH, D_MODEL, D_MODEL), D_MODEL ** -0.5),
        "norm_mix_post": gain((DEPTH, D_MODEL)),
        "norm_ffn_pre": gain((DEPTH, D_MODEL)),
        "ffn_w_gate": nrm((DEPTH, D_MODEL, D_FF), D_MODEL ** -0.5),
        "ffn_w_up": nrm((DEPTH, D_MODEL, D_FF), D_MODEL ** -0.5),
        "ffn_conv_w": nrm((DEPTH, CONV_WIDTH, D_FF), CONV_WIDTH ** -0.5),
        "ffn_conv_b": nrm((DEPTH, D_FF), 0.01),
        "ffn_w_down": nrm((DEPTH, D_FF, D_MODEL), D_FF ** -0.5),
        "norm_ffn_post": gain((DEPTH, D_MODEL)),
    }


def reference(x, meta_tokens, hgrn_lower_bounds, norm_mix_pre, w_in, hgrn_norm_w, gla_gate_up,
              gla_gate_bias, gla_norm_w, diff_lambda_q1, diff_lambda_k1, diff_lambda_q2,
              diff_lambda_k2, diff_subln_w, w_branch_hgrn, w_branch_gla, w_branch_diff, w_out,
              norm_mix_post, norm_ffn_pre, ffn_w_gate, ffn_w_up, ffn_conv_w, ffn_conv_b,
              ffn_w_down, norm_ffn_post):
    b = x.shape[0]
    meta = jnp.broadcast_to(meta_tokens.astype(x.dtype)[None], (b, N_META, D_MODEL))
    h = jnp.concatenate([meta, x], axis=1)
    lb_step = jax.nn.softmax(hgrn_lower_bounds.astype(jnp.float32), axis=0)
    lower_bounds = jnp.cumsum(lb_step, axis=0) - lb_step[0]
    split_at = np.cumsum(IN_SPLITS)[:-1].tolist()
    for layer in range(DEPTH):
        xn = rms_norm(h, norm_mix_pre[layer])
        (hq, hf, hi, hg, gq, gk, gv, gg, g_lr, dq, dk, dv,
         m_hgrn, m_gla, m_diff) = jnp.split(xn @ w_in[layer], split_at, axis=-1)
        o_hgrn = hgrn2_mixer(hq, hf, hi, hg, lower_bounds[layer], hgrn_norm_w[layer])
        o_gla = gla_mixer(gq, gk, gv, gg, g_lr, gla_gate_up[layer], gla_gate_bias[layer], gla_norm_w[layer])
        lambda_init = 0.8 - 0.6 * math.exp(-0.3 * layer)
        lam = (jnp.exp(jnp.sum(diff_lambda_q1[layer] * diff_lambda_k1[layer]).astype(jnp.float32))
               - jnp.exp(jnp.sum(diff_lambda_q2[layer] * diff_lambda_k2[layer]).astype(jnp.float32))
               + lambda_init)
        o_diff = diff_attention_mixer(dq, dk, dv, lam, lambda_init, diff_subln_w[layer])
        merged = (jax.nn.sigmoid(m_hgrn) * (o_hgrn @ w_branch_hgrn[layer])
                  + jax.nn.sigmoid(m_gla) * (o_gla @ w_branch_gla[layer])
                  + jax.nn.sigmoid(m_diff) * (o_diff @ w_branch_diff[layer]))
        h = h + rms_norm(merged @ w_out[layer], norm_mix_post[layer])
        xn = rms_norm(h, norm_ffn_pre[layer])
        f = conv_ffn(xn, ffn_w_gate[layer], ffn_w_up[layer], ffn_conv_w[layer], ffn_conv_b[layer], ffn_w_down[layer])
        h = h + rms_norm(f, norm_ffn_post[layer])
    return h[:, N_META:]
```

```cpp
#include <hip/hip_runtime.h>
#include <hip/hip_cooperative_groups.h>
#include <cstdio>
#include <cstdint>
namespace cg = cooperative_groups;

#define LAS __attribute__((address_space(3)))
typedef unsigned short u16;
typedef short bf16x8 __attribute__((ext_vector_type(8)));
typedef float f32x4 __attribute__((ext_vector_type(4)));
typedef unsigned u32x2 __attribute__((ext_vector_type(2)));
typedef unsigned u32x4 __attribute__((ext_vector_type(4)));

constexpr int NB = 2, TS = 8192, NMETA = 16, LSEQ = TS + NMETA, DM = 1024, DEPTH = 2;
constexpr int MREAL = NB * TS;
constexpr int MROWS = MREAL + NB * NMETA;
constexpr int DIN = 8208, DFF = 2816;
constexpr int NP = 5376;
constexpr float EPS = 1e-6f;
constexpr float LOG2E = 1.4426950408889634f;
constexpr int C_HQ = 0, C_HF = 512, C_HG = 1024, C_GG = 1536, C_DK = 2048, C_DV = 2560, C_GQ = 3072, C_GK = 3328, C_GL = 3584, C_HI = 3840, C_GV = 4352, C_DQ = 4864;
constexpr int S_HQ = 0, S_HF = 512, S_HI = 1024, S_HG = 1536, S_GQ = 2048, S_GK = 2304, S_GV = 2560, S_GG = 3072, S_GLR = 3584, S_DQ = 3600, S_DK = 4112, S_DV = 4624, S_M = 5136;

constexpr size_t MiB = 1u << 20;
constexpr size_t WS_CTL = 0;
constexpr size_t WS_LB = 64 * 1024;
constexpr size_t WS_LAM = 72 * 1024;
constexpr size_t WS_KMAX = 40960;
constexpr size_t WS_HM = 128 * 1024;
constexpr size_t WS_WTS = 2 * MiB;
constexpr size_t W_1T = WS_WTS;
constexpr size_t W_MT = W_1T + (size_t)NP * DM * 2;
constexpr size_t W_BR = W_MT + (size_t)3072 * DM * 2;
constexpr size_t W_OUT = W_BR + (size_t)3 * 1024 * 512 * 2;
constexpr size_t W_GU = WS_WTS;
constexpr size_t W_DN = W_GU + (size_t)5632 * DM * 2;
static_assert(W_DN + (size_t)DM * DFF * 2 <= W_BR, "ffn weights must not clobber Wbr/Wout");
constexpr size_t WS_XN = 24 * MiB;
constexpr size_t WS_SCAN = 57 * MiB;
constexpr size_t WS_ARENA = 83 * MiB;
constexpr size_t AR_Z = 96 * MiB;
static_assert(W_OUT + (size_t)DM * DM * 2 <= WS_XN, "weights region");
static_assert(WS_XN + (size_t)MROWS * DM * 2 <= WS_SCAN, "xn region");
constexpr size_t WS_END = WS_ARENA + (size_t)MROWS * NP * 2;
static_assert(WS_END <= 268435456, "ws budget");
static_assert((size_t)MROWS * DFF * 2 <= AR_Z && AR_Z + (size_t)MROWS * DM * 4 <= (size_t)MROWS * NP * 2, "arena overlay");

constexpr int LDS_BYTES = 147456;

struct Params { const float* in[26]; float* out; unsigned char* ws; };

__device__ __forceinline__ float bf2f(u16 x) { return __uint_as_float((unsigned)x << 16); }
__device__ __forceinline__ unsigned f2bf(float f) { unsigned u = __builtin_bit_cast(unsigned, f); return (u + 0x7fffu + ((u >> 16) & 1u)) >> 16; }
__device__ __forceinline__ unsigned pk2(float lo, float hi) { return f2bf(lo) | (f2bf(hi) << 16); }
__device__ __forceinline__ u16 f2h(float f) { return __builtin_bit_cast(u16, (_Float16)f); }
__device__ __forceinline__ float h2f(u16 x) { return (float)__builtin_bit_cast(_Float16, x); }
__device__ __forceinline__ float sigmoid_f(float x) { return 1.f / (1.f + __expf(-x)); }
__device__ __forceinline__ float silu_f(float x) { return x / (1.f + __expf(-x)); }
__device__ __forceinline__ float logsigmoid_f(float x) { return fminf(x, 0.f) - log1pf(__expf(-fabsf(x))); }
__device__ __forceinline__ float gelu_tanh_f(float x) { const float u = 0.7978845608028654f * (x + 0.044715f * x * x * x); const float t = 1.f - 2.f / (__expf(2.f * u) + 1.f); return 0.5f * x * (1.f + t); }
__device__ __forceinline__ float wave_sum(float v) {
#pragma unroll
    for (int o = 1; o < 64; o <<= 1) v += __shfl_xor(v, o);
    return v;
}
__device__ __forceinline__ int row_of(int b, int p) { return p < NMETA ? MREAL + b * NMETA + p : b * TS + (p - NMETA); }
__device__ __forceinline__ int prev_row(int r) {
    if (r < 0) return -1;
    if (r >= MREAL) { const int i = (r - MREAL) & 15; return i ? r - 1 : -1; }
    const int t = r & (TS - 1); if (t) return r - 1; return MREAL + (r >> 13) * NMETA + 15;
}

struct Ctx {
    const Params* pp; float* out; unsigned char* ws;
    int tid, lane, wave, G, gw, NGW;
    LAS unsigned char* lds;
    __device__ __forceinline__ float* hrow(int r) const { return r < MREAL ? out + (size_t)r * DM : (float*)(ws + WS_HM) + (size_t)(r - MREAL) * DM; }
    __device__ __forceinline__ u16* P() const { return (u16*)(ws + WS_ARENA); }
    __device__ __forceinline__ u16* XN() const { return (u16*)(ws + WS_XN); }
};

__device__ __forceinline__ Ctx fresh(const Ctx& c0) {
    Ctx c = c0;
    asm volatile("" : "+v"(c.tid));
    asm volatile("" : "+s"(c.wave), "+s"(c.G));
    asm volatile("" : "+s"(c.ws), "+s"(c.out));
    c.lane = c.tid & 63; c.gw = blockIdx.x * 8 + c.wave; c.NGW = c.G * 8;
    return c;
}
#define XB_TMO      128
#define XB_XCNT(j)  (256  + 64 * (j))
#define XB_XSUB(j)  (1280 + 64 * (j))
#define XB_XGEN(j)  (2304 + 64 * (j))
#define XB_TOP      3328
#define XB_TOPGEN   3392
#define XCD_BAR_WORDS 3456
#define XB_SPIN_CAP (1u << 20)
__device__ __forceinline__ unsigned xb_ld(unsigned* p)              { return __hip_atomic_load(p, __ATOMIC_RELAXED, __HIP_MEMORY_SCOPE_AGENT); }
__device__ __forceinline__ unsigned xb_add(unsigned* p, unsigned v) { return __hip_atomic_fetch_add(p, v, __ATOMIC_RELAXED, __HIP_MEMORY_SCOPE_AGENT); }
__device__ __forceinline__ unsigned xb_xcc_id() { return (unsigned)__builtin_amdgcn_s_getreg((3 << 11) | 20) & 0xFu; }
#define XB_SPIN(cond, bar) do { unsigned _sp = 0; while (cond) { __builtin_amdgcn_s_sleep(1); \
    if ((++_sp & 255u) == 0u) { if (xb_ld(&(bar)[XB_TMO])) break; if (_sp > XB_SPIN_CAP) { atomicAdd(&(bar)[XB_TMO], 1u); break; } } } } while (0)
struct XcdBarrier { unsigned* bar; unsigned x; volatile LAS unsigned* st; };
__device__ __forceinline__ XcdBarrier xcd_barrier_post(unsigned* bar, volatile LAS unsigned* st) {
    XcdBarrier b; b.bar = bar; b.x = xb_xcc_id(); b.st = st;
    if (threadIdx.x == 0) (void)xb_add(&bar[XB_XCNT(b.x)], 1u);
    return b;
}
__device__ __forceinline__ void xcd_barrier_complete(unsigned* bar, unsigned x, unsigned& nloc, unsigned& nx) {
    const unsigned G = gridDim.x * gridDim.y * gridDim.z;
    unsigned sum, cnt, mine, sp = 0u;
    for (;;) {
        sum = 0u; cnt = 0u; mine = 0u;
#pragma unroll
        for (unsigned j = 0; j < 16; ++j) { const unsigned c = xb_ld(&bar[XB_XCNT(j)]); sum += c; cnt += (c > 0u) ? 1u : 0u; mine = (j == x) ? c : mine; }
        if (sum == G) break;
        __builtin_amdgcn_s_sleep(1);
        if ((++sp & 255u) == 0u) { if (xb_ld(&bar[XB_TMO])) break; if (sp > XB_SPIN_CAP) { atomicAdd(&bar[XB_TMO], 1u); break; } }
    }
    nloc = mine > 0u ? mine : 1u; nx = cnt > 0u ? cnt : 1u;
}
__device__ __forceinline__ void xcd_barrier(const XcdBarrier& b) {
    asm volatile("s_waitcnt vmcnt(0)" ::: "memory");
    __syncthreads();
    if (threadIdx.x == 0) {
        unsigned* bar = b.bar;
        __builtin_amdgcn_s_waitcnt(0);
        unsigned nloc = b.st[0], nx = b.st[1];
        if (nloc == 0u) { xcd_barrier_complete(bar, b.x, nloc, nx); b.st[0] = nloc; b.st[1] = nx; }
        const unsigned old = xb_add(&bar[XB_XSUB(b.x)], 1u);
        const unsigned gen = old / nloc;
        if (old + 1u == (gen + 1u) * nloc) {
            __builtin_amdgcn_fence(__ATOMIC_RELEASE, "agent");
            asm volatile("s_waitcnt vmcnt(0)" ::: "memory");
            const unsigned og = xb_add(&bar[XB_TOP], 1u);
            const unsigned tg = og / nx;
            if (og + 1u == (tg + 1u) * nx) xb_add(&bar[XB_TOPGEN], 1u);
            else XB_SPIN(xb_ld(&bar[XB_TOPGEN]) == tg, bar);
            __builtin_amdgcn_fence(__ATOMIC_ACQUIRE, "agent");
            xb_add(&bar[XB_XGEN(b.x)], 1u);
            asm volatile("s_waitcnt vmcnt(0)" ::: "memory");
        } else {
            XB_SPIN(xb_ld(&bar[XB_XGEN(b.x)]) == gen, bar);
            __builtin_amdgcn_fence(__ATOMIC_ACQUIRE, "agent");
            asm volatile("s_waitcnt vmcnt(0)" ::: "memory");
        }
    }
    __syncthreads();
}
__device__ __forceinline__ void tr_item(const float* src, int ld, int scol0, u16* dst, int K, int n0, int k0, LAS float* scr, int lane) {
#pragma unroll 8
    for (int i = 0; i < 32; ++i) { const int kk = 2 * i + (lane >> 5); scr[kk * 33 + (lane & 31)] = src[(size_t)(k0 + kk) * ld + scol0 + (lane & 31)]; }
    asm volatile("s_waitcnt lgkmcnt(0)" ::: "memory");
    const int c = lane & 7;
#pragma unroll
    for (int j = 0; j < 4; ++j) { const int n = (lane >> 3) + 8 * j; const LAS float* s = scr + (8 * c) * 33 + n;
        u32x4 o; o.x = pk2(s[0 * 33], s[1 * 33]); o.y = pk2(s[2 * 33], s[3 * 33]); o.z = pk2(s[4 * 33], s[5 * 33]); o.w = pk2(s[6 * 33], s[7 * 33]);
        *(u32x4*)(dst + (size_t)(n0 + n) * K + k0 + 8 * c) = o; }
    asm volatile("s_waitcnt lgkmcnt(0)" ::: "memory");
}
__device__ __forceinline__ int p1_srccol(int c) {
    if (c < 512) return S_HQ + c;
    if (c < 1024) return S_HF + (c - 512);
    if (c < 1536) return S_HG + (c - 1024);
    if (c < 2048) return S_GG + (c - 1536);
    if (c < 2560) return S_DK + (c - 2048);
    if (c < 3072) return S_DV + (c - 2560);
    if (c < 3328) return S_GQ + (c - 3072);
    if (c < 3584) return S_GK + (c - 3328);
    if (c < 3840) return -1;
    if (c < 4352) return S_HI + (c - 3840);
    if (c < 4864) return S_GV + (c - 4352);
    return S_DQ + (c - 4864);
}
__device__ __forceinline__ void prep_weights_A(const Ctx& c, int l) {
    LAS float* scr = (LAS float*)(c.lds + c.wave * 8448);
    const float* w_in = c.pp->in[4] + (size_t)l * DM * DIN;
    constexpr int I1 = (NP / 32) * 16, I2 = (3072 / 32) * 16, I3 = 3 * 32 * 8, I4 = 32 * 16;
    for (int it = c.gw; it < I1 + I2 + I3 + I4; it += c.NGW) {
        int r = it;
        if (r < I1) { const int nb = r / 16, kb = r % 16; const int sc = p1_srccol(nb * 32); if (sc >= 0) tr_item(w_in, DIN, sc, (u16*)(c.ws + W_1T), DM, nb * 32, kb * 64, scr, c.lane); continue; } r -= I1;
        if (r < I2) { const int nb = r / 16, kb = r % 16; tr_item(w_in, DIN, S_M + nb * 32, (u16*)(c.ws + W_MT), DM, nb * 32, kb * 64, scr, c.lane); continue; } r -= I2;
        if (r < I3) { const int br = r / 256, q = r % 256, nb = q / 8, kb = q % 8; const float* src = c.pp->in[14 + br] + (size_t)l * 512 * DM;
            tr_item(src, DM, nb * 32, (u16*)(c.ws + W_BR) + (size_t)br * 1024 * 512, 512, nb * 32, kb * 64, scr, c.lane); continue; } r -= I3;
        { const int nb = r / 16, kb = r % 16; tr_item(c.pp->in[17] + (size_t)l * DM * DM, DM, nb * 32, (u16*)(c.ws + W_OUT), DM, nb * 32, kb * 64, scr, c.lane); }
    }
    const float* gup = c.pp->in[6] + (size_t)l * 16 * 256;
    for (int id = c.gw * 64 + c.lane; id < 256 * DM; id += c.NGW * 64) {
        const int k = id & (DM - 1), j = id >> 10; float s = 0.f;
#pragma unroll
        for (int r = 0; r < 16; ++r) s += w_in[(size_t)k * DIN + S_GLR + r] * gup[r * 256 + j];
        ((u16*)(c.ws + W_1T))[(size_t)(C_GL + j) * DM + k] = (u16)f2bf(s);
    }
}
__device__ __forceinline__ void prep_weights_B(const Ctx& c, int l) {
    LAS float* scr = (LAS float*)(c.lds + c.wave * 8448);
    constexpr int I1 = (5632 / 32) * 16, I2 = 32 * 44;
    for (int it = c.gw; it < I1 + I2; it += c.NGW) {
        int r = it;
        if (r < I1) { const int nb = r / 16, kb = r % 16, n0 = nb * 32, j = n0 >> 8, half = (n0 >> 7) & 1, c0 = n0 & 127;
            const float* src = c.pp->in[half ? 21 : 20] + (size_t)l * DM * DFF; tr_item(src, DFF, 128 * j + c0, (u16*)(c.ws + W_GU), DM, n0, kb * 64, scr, c.lane); continue; } r -= I1;
        { const int nb = r / 44, kb = r % 44; tr_item(c.pp->in[24] + (size_t)l * DFF * DM, DM, nb * 32, (u16*)(c.ws + W_DN), DFF, nb * 32, kb * 64, scr, c.lane); }
    }
}
__device__ __forceinline__ void prep_misc(const Ctx& c) {
    if (blockIdx.x == 0) {
        float* LB = (float*)(c.ws + WS_LB); const float* lbp = c.pp->in[2];
        for (int i = c.tid; i < 512; i += 512) { const float a = lbp[i], b = lbp[512 + i], m = fmaxf(a, b), ea = __expf(a - m), eb = __expf(b - m); LB[i] = 0.f; LB[512 + i] = eb / (ea + eb); }
        if (c.wave == 0) {
            for (int l = 0; l < DEPTH; ++l) {
                float s1 = c.pp->in[9][l * 64 + c.lane] * c.pp->in[10][l * 64 + c.lane], s2 = c.pp->in[11][l * 64 + c.lane] * c.pp->in[12][l * 64 + c.lane];
                s1 = wave_sum(s1); s2 = wave_sum(s2);
                const float linit = 0.8f - 0.6f * expf(-0.3f * (float)l);
                if (c.lane == 0) ((float*)(c.ws + WS_LAM))[l] = expf(s1) - expf(s2) + linit;
            }
        }
    }
}

__device__ __forceinline__ void row_pass(const float* src_h, float* dst_h, const float* y, const float* w_post, const float* w_next, u16* xn_row, int lane) {
    f32x4 hv[4];
#pragma unroll
    for (int j = 0; j < 4; ++j) hv[j] = ((const f32x4*)src_h)[lane + 64 * j];
    if (y) {
        f32x4 yv[4]; float ss = 0.f;
#pragma unroll
        for (int j = 0; j < 4; ++j) { yv[j] = ((const f32x4*)y)[lane + 64 * j]; ss += (yv[j].x * yv[j].x + yv[j].y * yv[j].y) + (yv[j].z * yv[j].z + yv[j].w * yv[j].w); }
        const float r = rsqrtf(wave_sum(ss) * (1.f / DM) + EPS);
#pragma unroll
        for (int j = 0; j < 4; ++j) { const f32x4 w = ((const f32x4*)w_post)[lane + 64 * j]; hv[j] = hv[j] + yv[j] * r * w; }
    }
    if (dst_h) {
#pragma unroll
        for (int j = 0; j < 4; ++j) ((f32x4*)dst_h)[lane + 64 * j] = hv[j];
    }
    if (xn_row) {
        float ss = 0.f;
#pragma unroll
        for (int j = 0; j < 4; ++j) ss += (hv[j].x * hv[j].x + hv[j].y * hv[j].y) + (hv[j].z * hv[j].z + hv[j].w * hv[j].w);
        const float r = rsqrtf(wave_sum(ss) * (1.f / DM) + EPS);
#pragma unroll
        for (int j = 0; j < 4; ++j) { const f32x4 w = ((const f32x4*)w_next)[lane + 64 * j]; const f32x4 o = hv[j] * r * w;
            u32x2 pk; pk.x = pk2(o.x, o.y); pk.y = pk2(o.z, o.w); ((u32x2*)xn_row)[lane + 64 * j] = pk; }
    }
}

template <int NT> __device__ __forceinline__ void wgemm16(const u16* ap  , bool avalid, const u16* bp  , size_t bstride  , int K, f32x4 (&acc)[NT]) {
    const bf16x8 z = {0, 0, 0, 0, 0, 0, 0, 0};
#pragma unroll 8
    for (int k0 = 0; k0 < K; k0 += 32) {
        bf16x8 a = *(const bf16x8*)(ap + k0); a = avalid ? a : z;
#pragma unroll
        for (int nt = 0; nt < NT; ++nt) { const bf16x8 b = *(const bf16x8*)(bp + nt * bstride + k0); acc[nt] = __builtin_amdgcn_mfma_f32_16x16x32_bf16(b, a, acc[nt], 0, 0, 0); }
    }
}
template <class Epi> __device__ __forceinline__ void phase_ngemm(const Ctx& c, const u16* A, int lda, int rg0, int rg1, const u16* Bt, int K, int N, const Epi& epi, int fb = 0) {
    const int ncg = N / 64, nu = (rg1 - rg0) * ncg, fr = c.lane & 15, fq = c.lane >> 4;
    if ((int)blockIdx.x < fb) return;
    for (int u = c.gw - fb * 8; u < nu; u += c.NGW - fb * 8) {
        const int rg = rg0 + u / ncg, cgi = u % ncg, row = rg * 16 + fr;
        f32x4 acc[4];
#pragma unroll
        for (int i = 0; i < 4; ++i) acc[i] = (f32x4){0.f, 0.f, 0.f, 0.f};
        wgemm16<4>(A + (size_t)row * lda + 8 * fq, true, Bt + (size_t)(cgi * 64 + fr) * K + 8 * fq, (size_t)16 * K, K, acc);
#pragma unroll
        for (int nt = 0; nt < 4; ++nt) epi(row, cgi * 64 + nt * 16 + 4 * fq, acc[nt]);
    }
}

__device__ __forceinline__ void store4_bf16(u16* p, f32x4 v) { u32x2 o; o.x = pk2(v.x, v.y); o.y = pk2(v.z, v.w); *(u32x2*)p = o; }
__device__ __forceinline__ void store4_h(u16* p, f32x4 v) { u32x2 o; o.x = (unsigned)f2h(v.x) | ((unsigned)f2h(v.y) << 16); o.y = (unsigned)f2h(v.z) | ((unsigned)f2h(v.w) << 16); *(u32x2*)p = o; }
struct EpiP1 {
    u16* P; const float* LB; const float* gbias; unsigned* kmax;
    __device__ __forceinline__ void operator()(int row, int col, f32x4 v) const {
        u16* dst = P + (size_t)row * NP + col;
        if (col < 512) { f32x4 o; o.x = silu_f(v.x); o.y = silu_f(v.y); o.z = silu_f(v.z); o.w = silu_f(v.w); store4_bf16(dst, o); }
        else if (col < 1024) { const f32x4 lb = *(const f32x4*)(LB + col - 512); f32x4 o;
            o.x = LOG2E * __logf(lb.x + (1.f - lb.x) * sigmoid_f(v.x)); o.y = LOG2E * __logf(lb.y + (1.f - lb.y) * sigmoid_f(v.y)); o.z = LOG2E * __logf(lb.z + (1.f - lb.z) * sigmoid_f(v.z)); o.w = LOG2E * __logf(lb.w + (1.f - lb.w) * sigmoid_f(v.w));
            store4_h(dst, o); }
        else if (col < 2048) { f32x4 o; o.x = silu_f(v.x); o.y = silu_f(v.y); o.z = silu_f(v.z); o.w = silu_f(v.w); store4_bf16(dst, o); }
        else if (col < 3072) { store4_bf16(dst, v);
            if (col < 2560) { const float mx = fmaxf(fmaxf(fabsf(v.x), fabsf(v.y)), fmaxf(fabsf(v.z), fabsf(v.w))); atomicMax(kmax + ((col - 2048) >> 7), __float_as_uint(mx)); } }
        else if (col < 3328) store4_bf16(dst, v * 0.125f);
        else if (col < 3584) store4_bf16(dst, v);
        else if (col < 3840) { const f32x4 bb = *(const f32x4*)(gbias + col - 3584); f32x4 o;
            o.x = logsigmoid_f(v.x + bb.x) * (0.0625f * LOG2E); o.y = logsigmoid_f(v.y + bb.y) * (0.0625f * LOG2E); o.z = logsigmoid_f(v.z + bb.z) * (0.0625f * LOG2E); o.w = logsigmoid_f(v.w + bb.w) * (0.0625f * LOG2E);
            store4_h(dst, o); }
        else if (col < 4864) store4_bf16(dst, v);
        else store4_bf16(dst, v * (0.125f * LOG2E));
    }
};
struct EpiSig {
    u16* P;
    __device__ __forceinline__ void operator()(int row, int col, f32x4 v) const { f32x4 o; o.x = sigmoid_f(v.x); o.y = sigmoid_f(v.y); o.z = sigmoid_f(v.z); o.w = sigmoid_f(v.w); store4_bf16(P + (size_t)row * NP + col, o); }
};
struct EpiF32 { float* Y; __device__ __forceinline__ void operator()(int row, int col, f32x4 v) const { *(f32x4*)(Y + (size_t)row * DM + col) = v; } };


namespace pg8 {
constexpr int BM = 256, BK = 64, HALF = 128, HTB = HALF * BK * 2, STAGE_BYTES = 8 * HTB, NXCD = 8, WGM = 8;
__host__ __device__ __forceinline__ int lds_byte(int r, int c) { const int st = (r >> 4) * 2 + (c >> 5), rr = r & 15, cc = c & 31, ob = rr * 64 + cc * 2; return st * 1024 + (ob ^ (((ob >> 9) & 1) << 5)); }
__host__ __device__ __forceinline__ void stage_rc(int b, int& R, int& C) { const int st = b / 1024, sb = b % 1024, swz = sb ^ (((sb >> 9) & 1) << 5); R = (st >> 1) * 16 + swz / 64; C = (st & 1) * 32 + (swz % 64) / 2; }
__host__ __device__ __forceinline__ int perm32(int rho) { const int n = rho >> 4, i = rho & 15; return 8 * (i >> 2) + 4 * n + (i & 3); }
struct Unit { int pm, pn, z; const char* A; const char* B; };
__device__ __forceinline__ bool static_tile(int i, int G, int c, int nM, int nN, int& pm, int& pn) {
    const int nwg = nM * nN; const long L = (long)i * G + c; if (L >= nwg) return false;
    int wgid = (int)L; { const int q = nwg / NXCD, r = nwg % NXCD, xcd = wgid % NXCD, off = wgid / NXCD; wgid = (xcd < r ? xcd * (q + 1) : r * (q + 1) + (xcd - r) * q) + off; }
    const int nig = WGM * nN, gid = wgid / nig, fm = gid * WGM, gsz = (nM - fm) < WGM ? (nM - fm) : WGM;
    pm = fm + ((wgid % nig) % gsz); pn = (wgid % nig) / gsz; return true;
}
template <class Epi, class Sched, bool ALIGN_EPI>
__device__ __forceinline__ void gemm_phase(LAS unsigned char* lds, const int lda, const int ldb, const int K, const Sched& S, const Epi& E) {
    int tid_ = threadIdx.x; asm volatile("" : "+v"(tid_));
    const int tid = tid_, wid = __builtin_amdgcn_readfirstlane(tid >> 6), lane = tid & 63, wr = wid >> 2, wc = wid & 3, fr = lane & 15, fq = lane >> 4;
    const int nt = K / BK;
    unsigned voffA[2], voffB[2];
#pragma unroll
    for (int i = 0; i < 2; ++i) { int R, C; stage_rc(tid * 16 + i * 8192, R, C); const int Rb = Epi::PERM ? ((R & ~31) + perm32(R & 31)) : R;
        voffA[i] = (unsigned)(R * lda + C) * 2u; voffB[i] = (unsigned)(Rb * ldb + C) * 2u; }
    const size_t kstep = (size_t)(BK * 2);
    const size_t hstepA = (size_t)HALF * lda * 2, hstepB = (size_t)HALF * ldb * 2;
    const unsigned ldsw = (unsigned)wid * 1024u;
    const int aoff = lds_byte(wr * 64 + fr, fq * 8), boff = lds_byte(wc * 32 + fr, fq * 8);
#define PG8_SA(b, h) (((b) * 2 + (h)) * HTB)
#define PG8_SB(b, h) ((4 + (b) * 2 + (h)) * HTB)
#define PG8_STAGE(bufoff, gbase, voff) do { _Pragma("unroll") for (int _i = 0; _i < 2; ++_i) \
        __builtin_amdgcn_global_load_lds((const unsigned*)((const char*)(gbase) + (voff)[_i]), (LAS unsigned*)(lds + (bufoff) + ldsw + _i * 8192), 16, 0, 0); } while (0)
#define PG8_LDA(dst, b, h) do { _Pragma("unroll") for (int m = 0; m < 4; ++m) _Pragma("unroll") for (int k = 0; k < 2; ++k) dst[m][k] = *(const LAS bf16x8*)(lds + PG8_SA(b, h) + aoff + m * 2048 + k * 1024); } while (0)
#define PG8_LDB(dst, b, h) do { _Pragma("unroll") for (int n = 0; n < 2; ++n) _Pragma("unroll") for (int k = 0; k < 2; ++k) dst[n][k] = *(const LAS bf16x8*)(lds + PG8_SB(b, h) + boff + n * 2048 + k * 1024); } while (0)
#define PG8_MMA(ai, bj, At, Bt) do { __builtin_amdgcn_s_setprio(1); _Pragma("unroll") for (int m = 0; m < 4; ++m) _Pragma("unroll") for (int n = 0; n < 2; ++n) _Pragma("unroll") for (int k = 0; k < 2; ++k) \
        acc[ai][bj][m][n] = __builtin_amdgcn_mfma_f32_16x16x32_bf16(Bt[n][k], At[m][k], acc[ai][bj][m][n], 0, 0, 0); __builtin_amdgcn_s_setprio(0); } while (0)
#define PG8_WAIT_V(n) asm volatile("s_waitcnt vmcnt(" #n ")" ::: "memory")
#define PG8_WAIT_L(n) asm volatile("s_waitcnt lgkmcnt(" #n ")" ::: "memory")
#define PG8_BAR __builtin_amdgcn_s_barrier()
#define PG8_SCHED __builtin_amdgcn_sched_barrier(0)
    Unit cur, nxt; int ui = 0;
    if (!S.next(0, cur)) return;
    f32x4 acc[2][2][4][2];
#pragma unroll
    for (int a = 0; a < 2; ++a)
#pragma unroll
        for (int b = 0; b < 2; ++b)
#pragma unroll
            for (int m = 0; m < 4; ++m)
#pragma unroll
                for (int n = 0; n < 2; ++n) acc[a][b][m][n] = (f32x4){0.f, 0.f, 0.f, 0.f};
    bf16x8 At[4][2], B0[2][2], B1[2][2];
    const char* cA = cur.A; const char* cB = cur.B;
    PG8_STAGE(PG8_SB(0, 0), cB, voffB); PG8_STAGE(PG8_SB(0, 1), cB + hstepB, voffB); PG8_STAGE(PG8_SA(0, 0), cA, voffA); PG8_STAGE(PG8_SA(0, 1), cA + hstepA, voffA);
    if (wr == 1) PG8_BAR;
    PG8_WAIT_V(2); PG8_BAR;
    PG8_STAGE(PG8_SB(1, 0), cB + kstep, voffB); PG8_STAGE(PG8_SA(1, 0), cA + kstep, voffA); PG8_STAGE(PG8_SB(1, 1), cB + hstepB + kstep, voffB);
    PG8_WAIT_V(6); PG8_BAR;
    for (;;) {
        const bool has_next = S.next(ui + 1, nxt);
        const char* nA = has_next ? nxt.A : cA; const char* nB = has_next ? nxt.B : cB;
        for (int t = 0; t < nt; t += 2) {
            const bool last = (t == nt - 2);
            const char* a1 = cA + (size_t)(t + 1) * kstep;
            const char* a2 = last ? nA : cA + (size_t)(t + 2) * kstep; const char* b2 = last ? nB : cB + (size_t)(t + 2) * kstep;
            const char* a3 = a2 + kstep; const char* b3 = b2 + kstep;
            PG8_LDB(B0, 0, 0); PG8_LDB(B1, 0, 1); PG8_SCHED; PG8_LDA(At, 0, 0); PG8_STAGE(PG8_SA(1, 1), a1 + hstepA, voffA);
            PG8_WAIT_V(8); PG8_WAIT_L(0); PG8_BAR; PG8_MMA(0, 0, At, B0); PG8_MMA(0, 1, At, B1); PG8_BAR; PG8_SCHED;
            PG8_LDA(At, 0, 1); PG8_STAGE(PG8_SB(0, 0), b2, voffB); PG8_STAGE(PG8_SB(0, 1), b2 + hstepB, voffB); PG8_STAGE(PG8_SA(0, 0), a2, voffA);
            PG8_WAIT_V(8); PG8_WAIT_L(0); PG8_BAR; PG8_MMA(1, 0, At, B0); PG8_MMA(1, 1, At, B1); PG8_BAR; PG8_SCHED;
            PG8_LDB(B0, 1, 0); PG8_LDB(B1, 1, 1); PG8_SCHED; PG8_LDA(At, 1, 0); PG8_STAGE(PG8_SA(0, 1), a2 + hstepA, voffA);
            PG8_WAIT_V(8); PG8_WAIT_L(0); PG8_BAR; PG8_MMA(0, 0, At, B0); PG8_MMA(0, 1, At, B1); PG8_BAR; PG8_SCHED;
            PG8_LDA(At, 1, 1); PG8_STAGE(PG8_SB(1, 0), b3, voffB); PG8_STAGE(PG8_SB(1, 1), b3 + hstepB, voffB); PG8_STAGE(PG8_SA(1, 0), a3, voffA);
            PG8_WAIT_V(8); PG8_WAIT_L(0); PG8_BAR; PG8_MMA(1, 0, At, B0); PG8_MMA(1, 1, At, B1); PG8_BAR; PG8_SCHED;
        }
        if constexpr (ALIGN_EPI) { if (wr == 0) PG8_BAR; }
        E(acc, cur, wr, wc, fr, fq);
        if (!has_next) break;
#pragma unroll
        for (int a = 0; a < 2; ++a)
#pragma unroll
            for (int b = 0; b < 2; ++b)
#pragma unroll
                for (int m = 0; m < 4; ++m)
#pragma unroll
                    for (int n = 0; n < 2; ++n) acc[a][b][m][n] = (f32x4){0.f, 0.f, 0.f, 0.f};
        cur = nxt; cA = nA; cB = nB; ++ui;
        if constexpr (ALIGN_EPI) { if (wr == 1) PG8_BAR; }
    }
    PG8_WAIT_V(0);
    if constexpr (!ALIGN_EPI) { if (wr == 0) PG8_BAR; }
    PG8_BAR;
#undef PG8_SA
#undef PG8_SB
#undef PG8_STAGE
#undef PG8_LDA
#undef PG8_LDB
#undef PG8_MMA
#undef PG8_WAIT_V
#undef PG8_WAIT_L
#undef PG8_BAR
#undef PG8_SCHED
}
struct PlainSched {
    const char* A; const char* Bt; size_t atile, btile; int nN, G, c;
    __device__ __forceinline__ bool next(int i, Unit& u) const { int pm, pn; if (!static_tile(i, G, c, 64, nN, pm, pn)) return false; u.pm = pm; u.pn = pn; u.z = 0; u.A = A + (size_t)pm * atile; u.B = Bt + (size_t)pn * btile; return true; }
};
template <class Gr, bool PERM_> struct EpiGran {
    static constexpr bool PERM = PERM_;
    Gr g;
    __device__ __forceinline__ void operator()(const f32x4 (&acc)[2][2][4][2], const Unit& u, int wr, int wc, int fr, int fq) const {
        int row0 = u.pm * BM + wr * 64 + fr, col0 = u.pn * BM + wc * 32 + (PERM_ ? 8 : 4) * fq;
        asm volatile("" : "+v"(row0), "+v"(col0));
#pragma unroll
        for (int ai = 0; ai < 2; ++ai)
#pragma unroll
            for (int m = 0; m < 4; ++m) { const int row = row0 + ai * HALF + m * 16;
#pragma unroll
                for (int bj = 0; bj < 2; ++bj)
#pragma unroll
                    for (int n = 0; n < 2; ++n) { const int col = col0 + bj * HALF + (PERM_ ? 4 * n : 16 * n); g(row, col, acc[ai][bj][m][n]); } }
    }
};
}

template <int TYPE> __device__ __forceinline__ void p1_gran(u16* dst, int col, f32x4 v, const float* LB, const float* gbias) {
    if (TYPE == 0) { f32x4 o; o.x = silu_f(v.x); o.y = silu_f(v.y); o.z = silu_f(v.z); o.w = silu_f(v.w); store4_bf16(dst, o); }
    else if (TYPE == 1) { const f32x4 lb = *(const f32x4*)(LB + col - 512); f32x4 o;
        o.x = LOG2E * __logf(lb.x + (1.f - lb.x) * sigmoid_f(v.x)); o.y = LOG2E * __logf(lb.y + (1.f - lb.y) * sigmoid_f(v.y)); o.z = LOG2E * __logf(lb.z + (1.f - lb.z) * sigmoid_f(v.z)); o.w = LOG2E * __logf(lb.w + (1.f - lb.w) * sigmoid_f(v.w));
        store4_h(dst, o); }
    else if (TYPE == 2) store4_bf16(dst, v);
    else if (TYPE == 3) store4_bf16(dst, v * 0.125f);
    else if (TYPE == 4) { const f32x4 bb = *(const f32x4*)(gbias + col - 3584); f32x4 o;
        o.x = logsigmoid_f(v.x + bb.x) * (0.0625f * LOG2E); o.y = logsigmoid_f(v.y + bb.y) * (0.0625f * LOG2E); o.z = logsigmoid_f(v.z + bb.z) * (0.0625f * LOG2E); o.w = logsigmoid_f(v.w + bb.w) * (0.0625f * LOG2E);
        store4_h(dst, o); }
    else store4_bf16(dst, v * (0.125f * LOG2E));
}
struct EpiP1Tile {
    static constexpr bool PERM = true;
    u16* P; const float* LB; const float* gbias; unsigned* kmax;
    template <int TYPE> __device__ __forceinline__ void run(const f32x4 (&acc)[2][2][4][2], const pg8::Unit& u, int wr, int wc, int fr, int fq) const {
        int row0 = u.pm * 256 + wr * 64 + fr, col0 = u.pn * 256 + wc * 32 + 8 * fq;
        asm volatile("" : "+v"(row0), "+v"(col0));
#pragma unroll
        for (int ai = 0; ai < 2; ++ai)
#pragma unroll
            for (int m = 0; m < 4; ++m) { const int row = row0 + ai * 128 + m * 16;
#pragma unroll
                for (int bj = 0; bj < 2; ++bj)
#pragma unroll
                    for (int n = 0; n < 2; ++n) { const int col = col0 + bj * 128 + 4 * n; p1_gran<TYPE == 6 ? 2 : TYPE>(P + (size_t)row * NP + col, col, acc[ai][bj][m][n], LB, gbias); } }
        if (TYPE == 6) {
#pragma unroll
            for (int bj = 0; bj < 2; ++bj) { float mx = 0.f;
#pragma unroll
                for (int ai = 0; ai < 2; ++ai)
#pragma unroll
                    for (int m = 0; m < 4; ++m)
#pragma unroll
                        for (int n = 0; n < 2; ++n) { const f32x4 v = acc[ai][bj][m][n]; mx = fmaxf(mx, fmaxf(fmaxf(fabsf(v.x), fabsf(v.y)), fmaxf(fabsf(v.z), fabsf(v.w)))); }
#pragma unroll
                for (int o = 1; o < 64; o <<= 1) mx = fmaxf(mx, __shfl_xor(mx, o));
                if (((fq << 4) | fr) == 0) atomicMax(kmax + (u.pn - 8) * 2 + bj, __float_as_uint(mx)); }
        }
    }
    __device__ __forceinline__ void operator()(const f32x4 (&acc)[2][2][4][2], const pg8::Unit& u, int wr, int wc, int fr, int fq) const {
        const int pn = u.pn;
        if (pn < 2) run<0>(acc, u, wr, wc, fr, fq);
        else if (pn < 4) run<1>(acc, u, wr, wc, fr, fq);
        else if (pn < 8) run<0>(acc, u, wr, wc, fr, fq);
        else if (pn < 10) run<6>(acc, u, wr, wc, fr, fq);
        else if (pn < 12) run<2>(acc, u, wr, wc, fr, fq);
        else if (pn == 12) run<3>(acc, u, wr, wc, fr, fq);
        else if (pn == 13) run<2>(acc, u, wr, wc, fr, fq);
        else if (pn == 14) run<4>(acc, u, wr, wc, fr, fq);
        else if (pn < 19) run<2>(acc, u, wr, wc, fr, fq);
        else run<5>(acc, u, wr, wc, fr, fq);
    }
};

struct EpiConvTile {
    static constexpr bool PERM = true;
    u16* ACT; const float* cw; const float* cb; LAS float* EX;
    __device__ __forceinline__ void operator()(f32x4 (&acc)[2][2][4][2], const pg8::Unit& u, int wr, int wc, int fr, int fq) const {
        int lane = (fq << 4) | fr, chl = wc * 32 + 8 * fq, row0 = u.pm * 256 + wr * 64 + fr;
        asm volatile("" : "+v"(lane), "+v"(chl), "+v"(row0));
        const int frr = lane & 15, src1 = (lane & 48) | ((frr + 15) & 15), src2 = (lane & 48) | ((frr + 14) & 15);
        if (frr >= 14) {
#pragma unroll
            for (int ai = 0; ai < 2; ++ai)
#pragma unroll
                for (int n = 0; n < 2; ++n) *(LAS f32x4*)(EX + ((ai * 2 + wr) * 2 + (frr - 14)) * 128 + chl + 4 * n) = acc[ai][0][3][n];
        }
        asm volatile("s_waitcnt lgkmcnt(0)" ::: "memory"); __builtin_amdgcn_s_barrier(); asm volatile("" ::: "memory");
#pragma unroll
        for (int n = 0; n < 2; ++n) {
            const int ch = u.pn * 128 + chl + 4 * n;
            const f32x4 w0 = *(const f32x4*)(cw + ch), w1 = *(const f32x4*)(cw + DFF + ch), w2 = *(const f32x4*)(cw + 2 * DFF + ch), bb = *(const f32x4*)(cb + ch);
#pragma unroll
            for (int ai = 0; ai < 2; ++ai) {
                const int hg = wr == 1 ? ai * 2 : (ai == 1 ? 1 : -1);
                f32x4 hm1 = (f32x4){0.f, 0.f, 0.f, 0.f}, hm2 = hm1;
                if (hg >= 0 && frr < 2) { hm1 = *(const LAS f32x4*)(EX + (hg * 2 + 1) * 128 + chl + 4 * n); hm2 = *(const LAS f32x4*)(EX + (hg * 2 + 0) * 128 + chl + 4 * n); }
#pragma unroll
                for (int m = 0; m < 4; ++m) {
                    const f32x4 x = acc[ai][0][m][n];
                    f32x4 p1, p2;
#pragma unroll
                    for (int e = 0; e < 4; ++e) {
                        const float a1 = __shfl(x[e], src1), a2 = __shfl(x[e], src2);
                        float b1, b2;
                        if (m > 0) { b1 = __shfl(acc[ai][0][m > 0 ? m - 1 : 0][n][e], src1); b2 = __shfl(acc[ai][0][m > 0 ? m - 1 : 0][n][e], src2); }
                        else { b1 = hm1[e]; b2 = frr == 0 ? hm2[e] : hm1[e]; }
                        p1[e] = frr >= 1 ? a1 : b1; p2[e] = frr >= 2 ? a2 : b2;
                    }
                    const f32x4 cv = bb + w0 * p2 + w1 * p1 + w2 * x; const f32x4 up = acc[ai][1][m][n];
                    f32x4 o; o.x = gelu_tanh_f(cv.x) * up.x; o.y = gelu_tanh_f(cv.y) * up.y; o.z = gelu_tanh_f(cv.z) * up.z; o.w = gelu_tanh_f(cv.w) * up.w;
                    const bool skip = (ai == 0 && m == 0 && wr == 0 && frr < 2);
                    if (!skip) store4_bf16(ACT + (size_t)(row0 + ai * 128 + m * 16) * DFF + ch, o);
                }
            }
        }
    }
};
struct EpiMergeTile {
    static constexpr bool PERM = true;
    const u16* P; u16* MG;
    __device__ __forceinline__ void operator()(const f32x4 (&acc)[2][2][4][2], const pg8::Unit& u, int wr, int wc, int fr, int fq) const {
        int row0 = u.pm * 256 + wr * 64 + fr, col0 = u.pn * 256 + wc * 32 + 8 * fq;
        asm volatile("" : "+v"(row0), "+v"(col0));
        const int br = u.z;
#pragma unroll
        for (int ai = 0; ai < 2; ++ai)
#pragma unroll
            for (int m = 0; m < 4; ++m) { const int row = row0 + ai * 128 + m * 16;
#pragma unroll
                for (int bj = 0; bj < 2; ++bj) { const int col = col0 + bj * 128;
                    const u32x4 g = *(const u32x4*)(P + (size_t)row * NP + br * 1024 + col);
                    u32x4 old = (u32x4){0u, 0u, 0u, 0u}; if (br > 0) old = *(const u32x4*)(MG + (size_t)row * DM + col);
                    const f32x4 a0 = acc[ai][bj][m][0], a1 = acc[ai][bj][m][1];
                    u32x4 o;
                    o.x = pk2(__uint_as_float(old.x << 16) + __uint_as_float(g.x << 16) * a0.x, __uint_as_float(old.x & 0xffff0000u) + __uint_as_float(g.x & 0xffff0000u) * a0.y);
                    o.y = pk2(__uint_as_float(old.y << 16) + __uint_as_float(g.y << 16) * a0.z, __uint_as_float(old.y & 0xffff0000u) + __uint_as_float(g.y & 0xffff0000u) * a0.w);
                    o.z = pk2(__uint_as_float(old.z << 16) + __uint_as_float(g.z << 16) * a1.x, __uint_as_float(old.z & 0xffff0000u) + __uint_as_float(g.z & 0xffff0000u) * a1.y);
                    o.w = pk2(__uint_as_float(old.w << 16) + __uint_as_float(g.w << 16) * a1.z, __uint_as_float(old.w & 0xffff0000u) + __uint_as_float(g.w & 0xffff0000u) * a1.w);
                    *(u32x4*)(MG + (size_t)row * DM + col) = o; } }
    }
};
struct MergeSched {
    const char* P; const char* Wbr; int G, c;
    __device__ __forceinline__ bool next(int i, pg8::Unit& u) const {
        int pm, pn; if (!pg8::static_tile(i / 3, G, c, 64, 4, pm, pn)) return false; const int br = i % 3;
        const int ocol = br == 0 ? C_HI : (br == 1 ? C_GV : C_DQ);
        u.pm = pm; u.pn = pn; u.z = br; u.A = P + ((size_t)pm * 256 * NP + ocol) * 2; u.B = Wbr + ((size_t)br * 1024 * 512 + (size_t)pn * 256 * 512) * 2; return true;
    }
};
__device__ __forceinline__ void phase_p3b_naive(const Ctx& c, int rg0, int rg1) {
    const u16* P = c.P(); u16* MG = c.XN();
    const int ncg = DM / 64, nu = (rg1 - rg0) * ncg, fr = c.lane & 15, fq = c.lane >> 4;
    for (int u = c.gw; u < nu; u += c.NGW) {
        const int rg = rg0 + u / ncg, cgi = u % ncg, row = rg * 16 + fr;
        f32x4 tot[4];
#pragma unroll
        for (int i = 0; i < 4; ++i) tot[i] = (f32x4){0.f, 0.f, 0.f, 0.f};
#pragma unroll 1
        for (int br = 0; br < 3; ++br) {
            const int ocol = br == 0 ? C_HI : (br == 1 ? C_GV : C_DQ);
            f32x4 acc[4];
#pragma unroll
            for (int i = 0; i < 4; ++i) acc[i] = (f32x4){0.f, 0.f, 0.f, 0.f};
            wgemm16<4>(P + (size_t)row * NP + ocol + 8 * fq, true, (const u16*)(c.ws + W_BR) + (size_t)br * 1024 * 512 + (size_t)(cgi * 64 + fr) * 512 + 8 * fq, (size_t)16 * 512, 512, acc);
#pragma unroll
            for (int nt = 0; nt < 4; ++nt) { const u32x2 g = *(const u32x2*)(P + (size_t)row * NP + br * 1024 + cgi * 64 + nt * 16 + 4 * fq);
                f32x4 gv; gv.x = __uint_as_float(g.x << 16); gv.y = __uint_as_float(g.x & 0xffff0000u); gv.z = __uint_as_float(g.y << 16); gv.w = __uint_as_float(g.y & 0xffff0000u);
                tot[nt] = tot[nt] + gv * acc[nt]; }
        }
#pragma unroll
        for (int nt = 0; nt < 4; ++nt) store4_bf16(MG + (size_t)row * DM + cgi * 64 + nt * 16 + 4 * fq, tot[nt]);
    }
}
template <int MODE> __device__ __forceinline__ void phase_p5_naive(const Ctx& c, int l, int rg0, int rg1, int fb) {
    const u16* XN = c.XN(); u16* ACT = (u16*)(c.ws + WS_ARENA); const u16* Wgu = (const u16*)(c.ws + W_GU);
    const float* cw = c.pp->in[22] + (size_t)l * 3 * DFF; const float* cb = c.pp->in[23] + (size_t)l * DFF;
    const int ncg = DFF / 16, nu = (rg1 - rg0) * ncg, fr = c.lane & 15, fq = c.lane >> 4;
    if ((int)blockIdx.x < fb) return;
    const bf16x8 z = {0, 0, 0, 0, 0, 0, 0, 0};
    for (int u = c.gw - fb * 8; u < nu; u += c.NGW - fb * 8) {
        const int rg = rg0 + u / ncg, cgi = u % ncg, row = MODE == 0 ? rg * 16 + fr : 256 * (8 * rg + (fr >> 1)) + (fr & 1), r1 = prev_row(row), r2 = prev_row(r1);
        const int ch0 = cgi * 16, j = ch0 >> 7, cin = ch0 & 127;
        const u16* a0 = XN + (size_t)row * DM + 8 * fq; const u16* a1 = XN + (size_t)(r1 < 0 ? 0 : r1) * DM + 8 * fq; const u16* a2 = XN + (size_t)(r2 < 0 ? 0 : r2) * DM + 8 * fq;
        const u16* bg = Wgu + (size_t)(256 * j + cin + fr) * DM + 8 * fq; const u16* bu = bg + (size_t)128 * DM;
        f32x4 g0 = {0.f, 0.f, 0.f, 0.f}, g1 = g0, g2 = g0, up = g0;
#pragma unroll 8
        for (int k0 = 0; k0 < DM; k0 += 32) {
            const bf16x8 wg = *(const bf16x8*)(bg + k0), wu = *(const bf16x8*)(bu + k0), x0 = *(const bf16x8*)(a0 + k0);
            bf16x8 x1 = *(const bf16x8*)(a1 + k0), x2 = *(const bf16x8*)(a2 + k0); x1 = r1 >= 0 ? x1 : z; x2 = r2 >= 0 ? x2 : z;
            g0 = __builtin_amdgcn_mfma_f32_16x16x32_bf16(wg, x0, g0, 0, 0, 0); up = __builtin_amdgcn_mfma_f32_16x16x32_bf16(wu, x0, up, 0, 0, 0);
            g1 = __builtin_amdgcn_mfma_f32_16x16x32_bf16(wg, x1, g1, 0, 0, 0); g2 = __builtin_amdgcn_mfma_f32_16x16x32_bf16(wg, x2, g2, 0, 0, 0);
        }
        const int ch = ch0 + 4 * fq;
        const f32x4 w0 = *(const f32x4*)(cw + ch), w1 = *(const f32x4*)(cw + DFF + ch), w2 = *(const f32x4*)(cw + 2 * DFF + ch), bb = *(const f32x4*)(cb + ch);
        const f32x4 cv = bb + w0 * g2 + w1 * g1 + w2 * g0;
        f32x4 o; o.x = gelu_tanh_f(cv.x) * up.x; o.y = gelu_tanh_f(cv.y) * up.y; o.z = gelu_tanh_f(cv.z) * up.z; o.w = gelu_tanh_f(cv.w) * up.w;
        store4_bf16(ACT + (size_t)row * DFF + ch, o);
    }
}

template <int DK, bool HGRN> __device__ __forceinline__ void scan_naive_unit(const Ctx& c, int l, int b, int h) {
    u16* P = c.P();
    LAS float* sq = (LAS float*)c.lds; LAS float* sa = sq + 128; LAS float* sk = sa + 128; LAS float* red = sk + 128;
    const int qc = HGRN ? C_HQ + h * 128 : C_GQ + h * 64, gc = HGRN ? C_HF + h * 128 : C_GL + h * 64, kc = C_GK + h * 64;
    const int vc = (HGRN ? C_HI : C_GV) + h * 128, gatec = (HGRN ? C_HG : C_GG) + h * 128;
    const float* nw = (HGRN ? c.pp->in[5] : c.pp->in[8]) + l * 128;
    constexpr int DH = DK / 2;
    float S[DH];
#pragma unroll
    for (int d = 0; d < DH; ++d) S[d] = 0.f;
    const int t = c.tid, col = (t >> 1) & 127, half = t & 1; const float wn = nw[col];
    for (int p = 0; p < LSEQ; ++p) {
        const int row = row_of(b, p); const u16* pr = P + (size_t)row * NP;
        if (t < DK) { const float a = exp2f(h2f(pr[gc + t])); sq[t] = bf2f(pr[qc + t]); sa[t] = a; sk[t] = HGRN ? 1.f - a : bf2f(pr[kc + t]); }
        __syncthreads();
        float o = 0.f;
        if (t < 256) {
            const float v = bf2f(pr[vc + col]);
#pragma unroll
            for (int d = 0; d < DH; ++d) { const int dd = half * DH + d; S[d] = sa[dd] * S[d] + sk[dd] * v; o += sq[dd] * S[d]; }
        }
        o += __shfl_xor(o, 1);
        const float ss = wave_sum(half == 0 ? o * o : 0.f);
        if (c.lane == 0) red[c.wave] = ss;
        __syncthreads();
        if (t < 256 && half == 0) {
            const float tot = (red[0] + red[1]) + (red[2] + red[3]); const float r = rsqrtf(tot * (1.f / 128.f) + EPS);
            P[(size_t)row * NP + vc + col] = (u16)f2bf(o * r * wn * bf2f(pr[gatec + col]));
        }
        __syncthreads();
    }
}
__device__ __forceinline__ void attn_naive_unit(const Ctx& c, int l, int b, int h, int qb) {
    u16* P = c.P();
    LAS u16* Ks = (LAS u16*)c.lds;
    LAS u16* Vs = Ks + 64 * 128;
    const int i = c.tid >> 3, m = (c.tid >> 2) & 1, part = c.tid & 3, pos = qb * 64 + i; const bool valid = pos < LSEQ;
    const int row = row_of(b, valid ? pos : 0);
    float q[64];
    { const u16* qp = P + (size_t)row * NP + C_DQ + h * 128 + m * 64;
#pragma unroll
      for (int d = 0; d < 64; ++d) q[d] = bf2f(qp[d]); }
    const float slope2 = exp2f(-2.f * (float)(h + 1)) * LOG2E;
    float o[32], mx = -1e30f, ls = 0.f;
#pragma unroll
    for (int e = 0; e < 32; ++e) o[e] = 0.f;
    __syncthreads();
    for (int kt = 0; kt <= qb; ++kt) {
        for (int cc = c.tid; cc < 64 * 32; cc += 512) { const int jj = cc >> 5, ch = cc & 31; const int pj = kt * 64 + jj; const int rj = row_of(b, pj < LSEQ ? pj : 0);
            const u16* src = P + (size_t)rj * NP + (ch < 16 ? C_DK + h * 128 + ch * 8 : C_DV + h * 128 + (ch - 16) * 8);
            const u32x4 v = *(const u32x4*)src; LAS u16* dst = (ch < 16 ? Ks + jj * 128 + ch * 8 : Vs + jj * 128 + (ch - 16) * 8); *(LAS u32x4*)dst = v; }
        __syncthreads();
        for (int jj = 0; jj < 64; ++jj) {
            const int pj = kt * 64 + jj;
            if (valid && pj <= pos) {
                float s = 0.f;
#pragma unroll
                for (int d = 0; d < 64; ++d) s += q[d] * bf2f(Ks[jj * 128 + m * 64 + d]);
                s -= slope2 * (float)(pos - pj);
                const float n1 = fmaxf(mx, s), c1 = exp2f(mx - n1), p1 = exp2f(s - n1); mx = n1; ls = ls * c1 + p1;
#pragma unroll
                for (int e = 0; e < 32; ++e) { const float v = bf2f(Vs[jj * 128 + part * 32 + e]); o[e] = o[e] * c1 + p1 * v; }
            }
        }
        __syncthreads();
    }
    const float lam = ((const float*)(c.ws + WS_LAM))[l]; const float linit = 0.8f - 0.6f * expf(-0.3f * (float)l);
    float ss = 0.f; const float il = valid ? 1.f / ls : 0.f;
#pragma unroll
    for (int e = 0; e < 32; ++e) { const float on = o[e] * il; const float other = __shfl_xor(on, 4); o[e] = on - lam * other; ss += o[e] * o[e]; }
    ss += __shfl_xor(ss, 1); ss += __shfl_xor(ss, 2);
    const float r = rsqrtf(ss * (1.f / 128.f) + EPS) * (1.f - linit);
    if (valid && m == 0) { const float* sw = c.pp->in[13] + l * 128 + part * 32; u16* dst = P + (size_t)row * NP + C_DQ + h * 128 + part * 32;
#pragma unroll
        for (int e = 0; e < 32; ++e) dst[e] = (u16)f2bf(o[e] * r * sw[e]); }
}

namespace fa {
typedef float f32x16 __attribute__((ext_vector_type(16)));
typedef short v4i16_t __attribute__((ext_vector_type(4)));
constexpr int KSTR = 272, VSTR = 320, KBUF = 64 * KSTR, VBUF = 64 * VSTR, STAGE = KBUF + VBUF, XOFF = 2 * STAGE, QSLOT = XOFF + 65536;
static_assert(QSLOT + 64 <= LDS_BYTES, "attention LDS map");
__device__ __forceinline__ constexpr int crowc(int r) { return (r & 3) + 8 * (r >> 2); }
__device__ __forceinline__ unsigned cvtpk(float lo, float hi) { typedef float f2 __attribute__((ext_vector_type(2))); typedef __bf16 b2 __attribute__((ext_vector_type(2))); f2 v = {lo, hi}; b2 b = __builtin_convertvector(v, b2); return __builtin_bit_cast(unsigned, b); }
template <bool DRY> __device__ __forceinline__ void attn_unit(const Ctx& c, int l, int b, int h, int qblk) {
    u16* P = c.P();
    const int tid = c.tid, lane = tid & 63, wave = c.wave, m = wave >> 2, wq = wave & 3, q31 = lane & 31, hi = lane >> 5;
    const bool meta = qblk < 0;
    const int qrow0 = meta ? 0 : 128 * qblk + 32 * wq;
    const bool wave_active = !meta || wq == 0;
    const int qi = qrow0 + q31;
    const bool qvalid = !meta || qi < 16;
    const int qrow = meta ? MREAL + 16 * b + (qvalid ? qi : 0) : b * TS + qi;
    const int posq = meta ? (qvalid ? qi : 0) : 16 + qi;
    const float slope2 = exp2f(-2.f * (float)(h + 1)) * LOG2E;
    bf16x8 qf[4];
    { const u16* qp = P + (size_t)qrow * NP + C_DQ + h * 128 + m * 64 + 8 * hi;
#pragma unroll
      for (int s = 0; s < 4; ++s) qf[s] = *(const bf16x8*)(qp + 16 * s); }
    float cr[16];
#pragma unroll
    for (int r = 0; r < 16; ++r) cr[r] = slope2 * (float)(crowc(r) + 4 * hi);
    f32x16 O[4];
#pragma unroll
    for (int i = 0; i < 4; ++i)
#pragma unroll
        for (int r = 0; r < 16; ++r) O[i][r] = 0.f;
    float mrun = -1e30f, lsum = 0.f;
    const int nreal = meta ? 0 : 2 * qblk + 2, NT = nreal + 1;
    float qb;
    { float s1 = 0.f;
#pragma unroll
      for (int s = 0; s < 4; ++s)
#pragma unroll
          for (int e = 0; e < 8; ++e) s1 += fabsf(__uint_as_float(((unsigned)(unsigned short)qf[s][e]) << 16));
      s1 += __shfl_xor(s1, 32);
      qb = s1 * __uint_as_float(((const unsigned*)(c.ws + WS_KMAX))[4 * l + h]) * 1.01f; }
    u32x4 kreg[2], vreg[2];
    auto load_tile = [&](int it) {
        const bool mt = it >= nreal; const int kt = nreal - 1 - it;
#pragma unroll
        for (int i = 0; i < 2; ++i) { const int cidx = tid + 512 * i, row = cidx >> 4, ch = cidx & 15;
            const bool ok = !mt || row < 16; const int grow = mt ? MREAL + 16 * b + (ok ? row : 0) : b * TS + 64 * kt + row;
            const u16* gp = P + (size_t)grow * NP + h * 128 + ch * 8;
            u32x4 kv = *(const u32x4*)(gp + C_DK), vv = *(const u32x4*)(gp + C_DV);
            if (!ok) { kv = (u32x4){0u, 0u, 0u, 0u}; vv = kv; }
            kreg[i] = kv; vreg[i] = vv; }
    };
    auto store_tile = [&](int buf) {
#pragma unroll
        for (int i = 0; i < 2; ++i) { const int cidx = tid + 512 * i, row = cidx >> 4, ch = cidx & 15;
            *(LAS u32x4*)(c.lds + buf * STAGE + row * KSTR + ch * 16) = kreg[i];
            *(LAS u32x4*)(c.lds + buf * STAGE + KBUF + row * VSTR + ch * 16) = vreg[i]; }
    };
    load_tile(0); store_tile(0);
    __syncthreads();
    const int li = lane & 15, G = lane >> 4;
    int cur = 0;
    for (int it = 0; it < NT; ++it) {
        if (it + 1 < NT) load_tile(it + 1);
        const bool mt = it >= nreal; const int kt = nreal - 1 - it;
        const int tbase = mt ? 0 : 16 + 64 * kt;
        const bool skip = !wave_active || (!mt && 64 * kt > qrow0 + 31);
        if (!skip) {
            const LAS unsigned char* sb = c.lds + cur * STAGE;
            const bool need_mask = mt || (64 * kt + 63 > qrow0);
            f32x16 p0, p1;
#pragma unroll
            for (int r = 0; r < 16; ++r) { p0[r] = 0.f; p1[r] = 0.f; }
            { const LAS unsigned char* kb = sb + q31 * KSTR + (m * 64 + 8 * hi) * 2;
#pragma unroll
              for (int s = 0; s < 4; ++s) { const bf16x8 a0 = *(const LAS bf16x8*)(kb + s * 32); p0 = __builtin_amdgcn_mfma_f32_32x32x16_bf16(a0, qf[s], p0, 0, 0, 0); }
              if (!mt) {
#pragma unroll
                  for (int s = 0; s < 4; ++s) { const bf16x8 a1 = *(const LAS bf16x8*)(kb + 32 * KSTR + s * 32); p1 = __builtin_amdgcn_mfma_f32_32x32x16_bf16(a1, qf[s], p1, 0, 0, 0); } } }
            const float base0 = slope2 * (float)(tbase - posq), base1 = slope2 * (float)(tbase + 32 - posq);
#pragma unroll
            for (int r = 0; r < 16; ++r) { p0[r] += base0 + cr[r]; p1[r] += base1 + cr[r]; }
            if (need_mask) {
                const int lim = min(posq - tbase, (mt ? 16 : 64) - 1) - 4 * hi;
#pragma unroll
                for (int r = 0; r < 16; ++r) { if (crowc(r) > lim) p0[r] = -1e30f; if (crowc(r) + 32 > lim) p1[r] = -1e30f; }
            }
            if (mt) {
#pragma unroll
                for (int r = 0; r < 16; ++r) p1[r] = -1e30f;
            }
            float mx = p0[0];
#pragma unroll
            for (int r = 1; r < 16; ++r) mx = fmaxf(mx, p0[r]);
#pragma unroll
            for (int r = 0; r < 16; ++r) mx = fmaxf(mx, p1[r]);
            mx = fmaxf(mx, __shfl_xor(mx, 32));
            if (__any(mx > mrun)) {
                const float mnew = fmaxf(mrun, mx), alpha = __builtin_amdgcn_exp2f(mrun - mnew); mrun = mnew; lsum *= alpha;
#pragma unroll
                for (int i = 0; i < 4; ++i)
#pragma unroll
                    for (int r = 0; r < 16; ++r) O[i][r] *= alpha;
            }
            float ps = 0.f;
#pragma unroll
            for (int r = 0; r < 16; ++r) { p0[r] = __builtin_amdgcn_exp2f(p0[r] - mrun); p1[r] = __builtin_amdgcn_exp2f(p1[r] - mrun); ps += p0[r] + p1[r]; }
            lsum += ps;
            bf16x8 pf[4];
#pragma unroll
            for (int s = 0; s < 4; ++s) { u32x4 w;
                if (s < 2) { w.x = cvtpk(p0[8 * s + 0], p0[8 * s + 1]); w.y = cvtpk(p0[8 * s + 2], p0[8 * s + 3]); w.z = cvtpk(p0[8 * s + 4], p0[8 * s + 5]); w.w = cvtpk(p0[8 * s + 6], p0[8 * s + 7]); }
                else { const int t = s - 2; w.x = cvtpk(p1[8 * t + 0], p1[8 * t + 1]); w.y = cvtpk(p1[8 * t + 2], p1[8 * t + 3]); w.z = cvtpk(p1[8 * t + 4], p1[8 * t + 5]); w.w = cvtpk(p1[8 * t + 6], p1[8 * t + 7]); }
                pf[s] = __builtin_bit_cast(bf16x8, w); }
            const LAS unsigned char* vb = sb + KBUF + (4 * (G >> 1) + (li >> 2)) * VSTR + (16 * (G & 1) + 4 * (li & 3)) * 2;
            const int nks = mt ? 2 : 4;
#pragma unroll
            for (int s = 0; s < 4; ++s) {
                if (s < nks) {
#pragma unroll
                    for (int blk = 0; blk < 4; ++blk) {
                        const v4i16_t t1 = __builtin_amdgcn_ds_read_tr16_b64_v4i16((LAS v4i16_t*)(vb + (16 * s) * VSTR + blk * 64));
                        const v4i16_t t2 = __builtin_amdgcn_ds_read_tr16_b64_v4i16((LAS v4i16_t*)(vb + (16 * s + 8) * VSTR + blk * 64));
                        const bf16x8 vf = {t1[0], t1[1], t1[2], t1[3], t2[0], t2[1], t2[2], t2[3]};
                        O[blk] = __builtin_amdgcn_mfma_f32_32x32x16_bf16(vf, pf[s], O[blk], 0, 0, 0);
                    }
                }
            }
        }
        bool jump = false;
        if (it + 1 < nreal) {
            const int maxpos = 16 + 64 * (kt - 1) + 63;
            const bool wdone = !wave_active || (qb + slope2 * (float)(maxpos - posq) - mrun < -150.f);
            jump = __syncthreads_and(__all(wdone) ? 1 : 0) != 0;
        }
        if (jump) { load_tile(nreal); store_tile(cur ^ 1); it = nreal - 1; }
        else if (it + 1 < NT) store_tile(cur ^ 1);
        cur ^= 1;
        __syncthreads();
    }
    lsum += __shfl_xor(lsum, 32);
    const float inv = 1.f / lsum;
    LAS float* X = (LAS float*)(c.lds + XOFF);
    if (m == 1) {
#pragma unroll
        for (int i = 0; i < 4; ++i)
#pragma unroll
            for (int r = 0; r < 16; ++r) X[(wq * 64 + i * 16 + r) * 64 + lane] = O[i][r] * inv;
    }
    __syncthreads();
    if (m == 0) {
        const float lam = ((const float*)(c.ws + WS_LAM))[l]; const float linit = 0.8f - 0.6f * expf(-0.3f * (float)l);
        float ss = 0.f;
#pragma unroll
        for (int i = 0; i < 4; ++i)
#pragma unroll
            for (int r = 0; r < 16; ++r) { const float d = O[i][r] * inv - lam * X[(wq * 64 + i * 16 + r) * 64 + lane]; O[i][r] = d; ss += d * d; }
        ss += __shfl_xor(ss, 32);
        const float rn = rsqrtf(ss * (1.f / 128.f) + EPS) * (1.f - linit);
        if (qvalid && wave_active && (!DRY || ss < -1.f)) {
            const float* sw = c.pp->in[13] + l * 128; u16* dst = P + (size_t)qrow * NP + C_DQ + h * 128;
#pragma unroll
            for (int i = 0; i < 4; ++i)
#pragma unroll
                for (int rq = 0; rq < 4; ++rq) { const int dv = 32 * i + 8 * rq + 4 * hi; const f32x4 w = *(const f32x4*)(sw + dv);
                    f32x4 o; o.x = O[i][4 * rq + 0] * rn * w.x; o.y = O[i][4 * rq + 1] * rn * w.y; o.z = O[i][4 * rq + 2] * rn * w.z; o.w = O[i][4 * rq + 3] * rn * w.w;
                    store4_bf16(dst + dv, o); }
        }
    }
    __syncthreads();
}
}

namespace scan {
constexpr int NSS = LSEQ / 16;
constexpr int NSEG = 8;
constexpr int OBOFF = 61440, OBS = 132;
constexpr int KHS = 64;
template <int DK> struct Lay { static constexpr int RS = DK * 2 + 16, QH = 0, QT = QH + 16 * RS, KT = QT + 16 * RS, KHT = KT + 16 * RS, VT = KHT + DK * KHS, DC = VT + 128 * KHS, SIZE = DC + DK * 4; };
static_assert(2 * Lay<128>::SIZE <= OBOFF && OBOFF + 64 * OBS * 4 <= 131072 && (Lay<128>::SIZE % 16) == 0 && (Lay<64>::SIZE % 16) == 0, "scan LDS map");
constexpr size_t SD_SLOT = 65536, SD_OFF = WS_SCAN, DG_OFF = WS_SCAN + 8 * MiB;
struct Raw { u32x2 q, g, k, v; };
__device__ __forceinline__ int rowss(int b, int ss, int tok) { return ss == 0 ? MREAL + 16 * b + tok : b * TS + 16 * (ss - 1) + tok; }
template <int N> __device__ __forceinline__ float dpp_shr(float x) { return __builtin_bit_cast(float, __builtin_amdgcn_update_dpp(0, __builtin_bit_cast(int, x), 0x110 + N, 0xf, 0xf, true)); }
__device__ __forceinline__ float ex2(float x) { return __builtin_amdgcn_exp2f(x); }
__device__ __forceinline__ unsigned cvtpk(float lo, float hi) { typedef float f2 __attribute__((ext_vector_type(2))); typedef __bf16 b2 __attribute__((ext_vector_type(2))); f2 v = {lo, hi}; b2 b = __builtin_convertvector(v, b2); return __builtin_bit_cast(unsigned, b); }
template <int DK, bool HGRN, int MODE, bool DRY> __device__ __forceinline__ void stream(const Ctx& c, int l, int st, int b, int h, int seg) {
    typedef Lay<DK> LY;
    typedef __attribute__((address_space(1))) u16 gu16; typedef __attribute__((address_space(1))) u32x2 gu32x2; typedef __attribute__((address_space(1))) float gf32; typedef __attribute__((address_space(1))) f32x4 gf32x4;
    gu16* P = (gu16*)c.P();
    const int tid = c.tid, lane = tid & 63, wave = c.wave, i16 = lane & 15, g4 = lane >> 4;
    const int qc = HGRN ? C_HQ + h * 128 : C_GQ + h * 64, gc = HGRN ? C_HF + h * 128 : C_GL + h * 64, kc = C_GK + h * 64;
    const int vc = (HGRN ? C_HI : C_GV) + h * 128, gatec = (HGRN ? C_HG : C_GG) + h * 128;
    const float* nw = (HGRN ? c.pp->in[5] : c.pp->in[8]) + l * 128;
    const bool pact = wave < DK / 16;
    const int d0 = pact ? 16 * wave + 4 * g4 : 0;
    const int vtok = tid & 15, vdq = tid >> 4;
    const int ss_b = seg == 0 ? 0 : 64 * seg + 1, ss_e = 64 * seg + 65;
    gf32* SD = (gf32*)(c.ws + SD_OFF); gf32* DG = (gf32*)(c.ws + DG_OFF);
    unsigned* cnt = (unsigned*)(c.ws + WS_CTL) + 2048 + 64 * (l * 16 + st);
    float gsum[4] = {0.f, 0.f, 0.f, 0.f};
    auto load_raw = [&](int ss) -> Raw {
        Raw R; if (ss > NSS - 1) ss = NSS - 1;
        const gu16* pr = P + (size_t)rowss(b, ss, i16) * NP;
        R.q = MODE == 0 ? (u32x2){0u, 0u} : *(const gu32x2*)(pr + qc + d0); R.g = *(const gu32x2*)(pr + gc + d0); R.k = HGRN ? (u32x2){0u, 0u} : *(const gu32x2*)(pr + kc + d0);
        R.v = *(const gu32x2*)(P + (size_t)rowss(b, ss, vtok) * NP + vc + 4 * vdq);
        return R;
    };
    auto prep = [&](const Raw& R, int buf) {
        LAS unsigned char* B = c.lds + buf * LY::SIZE;
        if (pact) {
            float gg[4], q[4], k[4];
            gg[0] = h2f((u16)(R.g.x & 0xffffu)); gg[1] = h2f((u16)(R.g.x >> 16)); gg[2] = h2f((u16)(R.g.y & 0xffffu)); gg[3] = h2f((u16)(R.g.y >> 16));
            q[0] = __uint_as_float(R.q.x << 16); q[1] = __uint_as_float(R.q.x & 0xffff0000u); q[2] = __uint_as_float(R.q.y << 16); q[3] = __uint_as_float(R.q.y & 0xffff0000u);
            if (HGRN) {
#pragma unroll
                for (int e = 0; e < 4; ++e) k[e] = 1.f - ex2(gg[e]);
            } else { k[0] = __uint_as_float(R.k.x << 16); k[1] = __uint_as_float(R.k.x & 0xffff0000u); k[2] = __uint_as_float(R.k.y << 16); k[3] = __uint_as_float(R.k.y & 0xffff0000u); }
            float qh[4], qt[4], kt[4], kh[4], dl[4];
#pragma unroll
            for (int e = 0; e < 4; ++e) {
                float x = gg[e];
                x += dpp_shr<1>(x); x += dpp_shr<2>(x); x += dpp_shr<4>(x); x += dpp_shr<8>(x);
                const float gl = __shfl(x, lane | 15);
                kh[e] = k[e] * ex2(gl - x); dl[e] = ex2(gl); gsum[e] += gl;
                if (MODE == 1) { const float gmid = __shfl(x, (lane & 48) | 7); qh[e] = q[e] * ex2(x); qt[e] = q[e] * ex2(x - gmid); kt[e] = k[e] * ex2(gmid - x); }
            }
            if (MODE == 1) {
                u32x2 w;
                w.x = cvtpk(qh[0], qh[1]); w.y = cvtpk(qh[2], qh[3]); *(LAS u32x2*)(B + LY::QH + i16 * LY::RS + d0 * 2) = w;
                w.x = cvtpk(qt[0], qt[1]); w.y = cvtpk(qt[2], qt[3]); *(LAS u32x2*)(B + LY::QT + i16 * LY::RS + d0 * 2) = w;
                w.x = cvtpk(kt[0], kt[1]); w.y = cvtpk(kt[2], kt[3]); *(LAS u32x2*)(B + LY::KT + i16 * LY::RS + d0 * 2) = w;
            }
            { const unsigned k01 = cvtpk(kh[0], kh[1]), k23 = cvtpk(kh[2], kh[3]); LAS unsigned char* kp = B + LY::KHT + d0 * KHS + (i16 >> 2) * 16 + (i16 & 3) * 2;
              *(LAS u16*)(kp) = (u16)(k01 & 0xffffu); *(LAS u16*)(kp + KHS) = (u16)(k01 >> 16); *(LAS u16*)(kp + 2 * KHS) = (u16)(k23 & 0xffffu); *(LAS u16*)(kp + 3 * KHS) = (u16)(k23 >> 16); }
            if (i16 == 15) *(LAS f32x4*)(B + LY::DC + d0 * 4) = (f32x4){dl[0], dl[1], dl[2], dl[3]};
        }
        { const unsigned v0 = R.v.x, v1 = R.v.y; LAS unsigned char* vt = B + LY::VT + (4 * vdq) * KHS + (vtok >> 2) * 16 + (vtok & 3) * 2;
          *(LAS u16*)(vt) = (u16)(v0 & 0xffffu); *(LAS u16*)(vt + KHS) = (u16)(v0 >> 16); *(LAS u16*)(vt + 2 * KHS) = (u16)(v1 & 0xffffu); *(LAS u16*)(vt + 3 * KHS) = (u16)(v1 >> 16); }
    };
    f32x4 T[DK / 16];
#pragma unroll
    for (int r = 0; r < DK / 16; ++r) T[r] = (f32x4){0.f, 0.f, 0.f, 0.f};
    LAS float* OB = (LAS float*)(c.lds + OBOFF);
#define SC_BAR() do { asm volatile("s_waitcnt lgkmcnt(0)" ::: "memory"); __builtin_amdgcn_s_barrier(); asm volatile("" ::: "memory"); } while (0)
    for (int i = tid; i < 2 * (DK + 128) * 4; i += 512) { const int buf = i / ((DK + 128) * 4), j = i % ((DK + 128) * 4); *(LAS u32x2*)(c.lds + buf * LY::SIZE + LY::KHT + j * 16 + 8) = (u32x2){0u, 0u}; }
    if (MODE == 1 && seg > 0) {
        if (tid == 0) { unsigned sp = 0; while (__hip_atomic_load(cnt, __ATOMIC_RELAXED, __HIP_MEMORY_SCOPE_AGENT) < (unsigned)(NSEG - 1)) { __builtin_amdgcn_s_sleep(8); if (++sp > (1u << 22)) break; }
            __builtin_amdgcn_fence(__ATOMIC_ACQUIRE, "agent"); asm volatile("s_waitcnt vmcnt(0)" ::: "memory"); }
        __syncthreads();
#pragma unroll 1
        for (int s2 = 0; s2 < seg; ++s2) {
            const gf32* sd = SD + (size_t)(st * (NSEG - 1) + s2) * (SD_SLOT / 4); const gf32* dg = DG + (size_t)(st * NSEG + s2) * 128;
#pragma unroll
            for (int r = 0; r < DK / 16; ++r) { const f32x4 dec = *(const gf32x4*)(dg + 16 * r + 4 * g4);
#pragma unroll
                for (int e = 0; e < 4; ++e) T[r][e] = T[r][e] * dec[e] + sd[(size_t)(16 * r + 4 * g4 + e) * 128 + 16 * wave + i16]; }
        }
    }
    auto mfma_stage = [&](int ss) {
        const LAS unsigned char* B = c.lds + (ss & 1) * LY::SIZE;
        const bf16x8 vf = *(const LAS bf16x8*)(B + LY::VT + (16 * wave + i16) * KHS + 16 * g4);
        if (MODE == 1) {
            f32x4 o = (f32x4){0.f, 0.f, 0.f, 0.f};
#pragma unroll
            for (int s = 0; s < DK / 32; ++s) {
                const u32x2 alo = *(const LAS u32x2*)(B + LY::QH + i16 * LY::RS + (32 * s + 4 * g4) * 2), ahi = *(const LAS u32x2*)(B + LY::QH + i16 * LY::RS + (32 * s + 16 + 4 * g4) * 2);
                const u32x4 aw = {alo.x, alo.y, ahi.x, ahi.y};
                u32x4 bw; bw.x = cvtpk(T[2 * s][0], T[2 * s][1]); bw.y = cvtpk(T[2 * s][2], T[2 * s][3]); bw.z = cvtpk(T[2 * s + 1][0], T[2 * s + 1][1]); bw.w = cvtpk(T[2 * s + 1][2], T[2 * s + 1][3]);
                o = __builtin_amdgcn_mfma_f32_16x16x32_bf16(__builtin_bit_cast(bf16x8, aw), __builtin_bit_cast(bf16x8, bw), o, 0, 0, 0);
            }
            f32x4 at = (f32x4){0.f, 0.f, 0.f, 0.f};
#pragma unroll
            for (int s = 0; s < DK / 32; ++s) {
                const bf16x8 ka = *(const LAS bf16x8*)(B + LY::KT + i16 * LY::RS + (32 * s + 8 * g4) * 2), qa = *(const LAS bf16x8*)(B + LY::QT + i16 * LY::RS + (32 * s + 8 * g4) * 2);
                at = __builtin_amdgcn_mfma_f32_16x16x32_bf16(ka, qa, at, 0, 0, 0);
            }
#pragma unroll
            for (int r = 0; r < 4; ++r) if (4 * g4 + r > i16) at[r] = 0.f;
            const bf16x8 a16 = __builtin_bit_cast(bf16x8, (u32x4){cvtpk(at[0], at[1]), cvtpk(at[2], at[3]), 0u, 0u});
            o = __builtin_amdgcn_mfma_f32_16x16x32_bf16(a16, vf, o, 0, 0, 0);
            const int slot = ss == 0 ? 0 : ((ss - 1) & 3);
#pragma unroll
            for (int r = 0; r < 4; ++r) OB[(slot * 16 + 4 * g4 + r) * OBS + 16 * wave + i16] = o[r];
        }
#pragma unroll
        for (int r = 0; r < DK / 16; ++r) {
            const f32x4 dec = *(const LAS f32x4*)(B + LY::DC + (16 * r + 4 * g4) * 4);
            const bf16x8 kh = *(const LAS bf16x8*)(B + LY::KHT + (16 * r + i16) * KHS + 16 * g4);
            T[r] = __builtin_amdgcn_mfma_f32_16x16x32_bf16(kh, vf, T[r] * dec, 0, 0, 0);
        }
    };
    Raw RA, RB;
    const int ntok_part = tid >> 3, part = tid & 7;
    LAS float* NWL = (LAS float*)(c.lds + OBOFF + 64 * OBS * 4);
    if (MODE == 1 && tid < 128) NWL[tid] = nw[tid];
    auto step = [&](int ss, Raw& RX, const bool gend) {
        u32x2 gw[4]; const int ntok = ss == 0 ? 16 : 64; const int nrow = ss == 0 ? MREAL + 16 * b + (ntok_part & 15) : b * TS + 16 * (ss - 4) + ntok_part;
        if (MODE == 1 && gend) { const gu16* gp = P + (size_t)nrow * NP + gatec + 16 * part;
#pragma unroll
            for (int j = 0; j < 4; ++j) gw[j] = *(const gu32x2*)(gp + 4 * j); }
        if (wave < 4) { if (ss + 1 < ss_e) prep(RX, (ss + 1) & 1); RX = load_raw(ss + 3); mfma_stage(ss); }
        else          { mfma_stage(ss); if (ss + 1 < ss_e) prep(RX, (ss + 1) & 1); RX = load_raw(ss + 3); }
        SC_BAR();
        if (MODE == 1 && gend) {
            if (ntok_part < ntok && (!DRY || T[0][0] == 12345.678f)) {
                f32x4 ov[4]; float sq = 0.f;
#pragma unroll
                for (int j = 0; j < 4; ++j) { ov[j] = *(const LAS f32x4*)(OB + ntok_part * OBS + 16 * part + 4 * j); sq += (ov[j].x * ov[j].x + ov[j].y * ov[j].y) + (ov[j].z * ov[j].z + ov[j].w * ov[j].w); }
                sq += __shfl_xor(sq, 1); sq += __shfl_xor(sq, 2); sq += __shfl_xor(sq, 4);
                const float rn = rsqrtf(sq * (1.f / 128.f) + EPS);
                gu16* op = P + (size_t)nrow * NP + vc + 16 * part;
#pragma unroll
                for (int j = 0; j < 4; ++j) { const f32x4 w = *(const LAS f32x4*)(NWL + 16 * part + 4 * j);
                    u32x2 ow; ow.x = cvtpk(ov[j].x * rn * w.x * __uint_as_float(gw[j].x << 16), ov[j].y * rn * w.y * __uint_as_float(gw[j].x & 0xffff0000u));
                    ow.y = cvtpk(ov[j].z * rn * w.z * __uint_as_float(gw[j].y << 16), ov[j].w * rn * w.w * __uint_as_float(gw[j].y & 0xffff0000u));
                    *(gu32x2*)(op + 4 * j) = ow; }
            }
            SC_BAR();
        }
    };
    if (seg == 0) {
        { const Raw R0 = load_raw(0); prep(R0, 0); }
        RA = load_raw(1); RB = load_raw(2);
        SC_BAR();
        step(0, RA, true);
#pragma unroll 1
        for (int ss = 1; ss < ss_e; ss += 4) { step(ss, RB, false); step(ss + 1, RA, false); step(ss + 2, RB, false); step(ss + 3, RA, true); }
    } else {
        { const Raw R0 = load_raw(ss_b); prep(R0, ss_b & 1); }
        RA = load_raw(ss_b + 1); RB = load_raw(ss_b + 2);
        SC_BAR();
#pragma unroll 1
        for (int ss = ss_b; ss < ss_e; ss += 4) { step(ss, RA, false); step(ss + 1, RB, false); step(ss + 2, RA, false); step(ss + 3, RB, true); }
    }
    if (MODE == 0) {
        gf32* sd = SD + (size_t)(st * (NSEG - 1) + seg) * (SD_SLOT / 4);
#pragma unroll
        for (int r = 0; r < DK / 16; ++r)
#pragma unroll
            for (int e = 0; e < 4; ++e) sd[(size_t)(16 * r + 4 * g4 + e) * 128 + 16 * wave + i16] = T[r][e];
        if (pact && i16 == 15) *(gf32x4*)(DG + (size_t)(st * NSEG + seg) * 128 + d0) = (f32x4){ex2(gsum[0]), ex2(gsum[1]), ex2(gsum[2]), ex2(gsum[3])};
        asm volatile("s_waitcnt vmcnt(0)" ::: "memory");
        __syncthreads();
        if (tid == 0) { __builtin_amdgcn_fence(__ATOMIC_RELEASE, "agent"); asm volatile("s_waitcnt vmcnt(0)" ::: "memory"); __hip_atomic_fetch_add(cnt, 1u, __ATOMIC_RELAXED, __HIP_MEMORY_SCOPE_AGENT); }
    }
    asm volatile("s_waitcnt vmcnt(0)" ::: "memory");
#undef SC_BAR
}
}
#ifndef PROBE_MODE
#define PROBE_MODE 0
#endif
template <bool DRY, bool SCANS, bool ATTN> __device__ __forceinline__ void phase_p2(const Ctx& c0, int l0, int qsel) {
    constexpr int NA = 16 * (scan::NSEG - 1), NB_ = 16 * scan::NSEG, NH = 144, NATT = NB * 4 * 64 + NB * 4, NU = NA + NATT + NB_;
    for (;;) {
        const Ctx c = fresh(c0); int l = l0; asm volatile("" : "+s"(l));
        unsigned* qctr = (unsigned*)(c.ws + WS_CTL) + 1024 + 64 * (2 * l + qsel);
        volatile LAS int* slot = (volatile LAS int*)(c.lds + fa::QSLOT);
        if (c.tid == 0) *slot = (int)atomicAdd(qctr, 1u);
        __syncthreads();
        const int u = *slot;
        __syncthreads();
        if (u >= NU) break;
        int a = -1;
        if (u < NA) {
            if (SCANS) { const int st = u / (scan::NSEG - 1), seg = u % (scan::NSEG - 1), b = (st >> 2) & 1, h = st & 3;
                if (st < 8) scan::stream<128, true, 0, DRY>(c, l, st, b, h, seg); else scan::stream<64, false, 0, DRY>(c, l, st, b, h, seg); }
        } else if (u < NA + NH) a = u - NA;
        else if (u < NA + NH + NB_) {
            if (SCANS) { const int v = u - NA - NH, st = v / scan::NSEG, seg = v % scan::NSEG, b = (st >> 2) & 1, h = st & 3;
                if (st < 8) scan::stream<128, true, 1, DRY>(c, l, st, b, h, seg); else scan::stream<64, false, 1, DRY>(c, l, st, b, h, seg); }
        } else a = u - NA - NB_;
        if (ATTN && a >= 0) {
            if (a < 512) { int qblk, b, h;
                if (a < 256) { qblk = 63 - (a >> 2); b = (a >> 1) & 1; h = 2 + (a & 1); }
                else { const int a2 = a - 256; h = a2 < 128 ? 1 : 0; const int a3 = a2 & 127; qblk = 63 - (a3 >> 1); b = a3 & 1; }
                fa::attn_unit<DRY>(c, l, b, h, qblk); }
            else { const int bh = a - 512; fa::attn_unit<DRY>(c, l, bh >> 2, bh & 3, -1); }
        }
        __syncthreads();
    }
}
__device__ __forceinline__ void phase_p2_naive(const Ctx& c, int l) {
    constexpr int NQB = (LSEQ + 63) / 64;
    const int nattn = NB * 4 * NQB, ntot = nattn + 16;
    for (int u = blockIdx.x; u < ntot; u += c.G) {
        if (u < 16) { const int mixer = u >> 3, b = (u >> 2) & 1, h = u & 3; if (mixer == 0) scan_naive_unit<128, true>(c, l, b, h); else scan_naive_unit<64, false>(c, l, b, h); }
        else { const int a = u - 16; const int qb = NQB - 1 - a / 8, bh = a % 8; attn_naive_unit(c, l, bh >> 2, bh & 3, qb); }
        __syncthreads();
    }
}

__global__ void __launch_bounds__(512, 2) mega_fwd(Params prm) {
    extern __shared__ __attribute__((aligned(16))) unsigned char lds_raw[];
    cg::grid_group grid = cg::this_grid();
    Ctx c0;
    c0.pp = &prm; c0.out = prm.out; c0.ws = prm.ws;
    c0.tid = threadIdx.x; c0.lane = c0.tid & 63; c0.wave = __builtin_amdgcn_readfirstlane(c0.tid >> 6); c0.G = gridDim.x; c0.gw = blockIdx.x * 8 + c0.wave; c0.NGW = c0.G * 8;
    c0.lds = (LAS unsigned char*)lds_raw;
    constexpr int RG_ALL = MROWS / 16, RG_REAL = MREAL / 16;
    for (int u = c0.tid; u < 64; u += 512) ((LAS unsigned*)(c0.lds + LDS_BYTES - 256))[u] = 0u;
    __syncthreads();
    const XcdBarrier xbar = xcd_barrier_post((unsigned*)(c0.ws + WS_CTL) + 4096, (volatile LAS unsigned*)(c0.lds + LDS_BYTES - 256));
#define GSYNC() xcd_barrier(xbar)

    { const Ctx c = fresh(c0);
      prep_misc(c);
      prep_weights_A(c, 0);
      for (int r = c.gw; r < MROWS; r += c.NGW) {
          const float* src = r < MREAL ? c.pp->in[0] + (size_t)r * DM : c.pp->in[1] + (size_t)((r - MREAL) & 15) * DM;
          row_pass(src, c.hrow(r), nullptr, nullptr, c.pp->in[3], c.XN() + (size_t)r * DM, c.lane);
      } }
    grid.sync();
#pragma unroll 1
    for (int l = 0; l < DEPTH; ++l) {
        for (int rep = 0; rep < ((PROBE_MODE == 3) ? 2 : 1); ++rep) {
        { const Ctx c = fresh(c0); const float* LBl = (const float*)(c.ws + WS_LB) + l * 512; const float* gb = c.pp->in[7] + l * 256;
          pg8::PlainSched S{(const char*)c.XN(), (const char*)(c.ws + W_1T), (size_t)256 * DM * 2, (size_t)256 * DM * 2, NP / 256, c.G, (int)blockIdx.x};
          EpiP1Tile et{c.P(), LBl, gb, (unsigned*)(c.ws + WS_KMAX) + 4 * l}; pg8::gemm_phase<EpiP1Tile, pg8::PlainSched, true>(c.lds, DM, DM, DM, S, et); }
        { const Ctx c = fresh(c0); const float* LBl = (const float*)(c.ws + WS_LB) + l * 512; const float* gb = c.pp->in[7] + l * 256;
          EpiP1 e{c.P(), LBl, gb, (unsigned*)(c.ws + WS_KMAX) + 4 * l}; phase_ngemm(c, c.XN(), DM, RG_REAL, RG_ALL, (const u16*)(c.ws + W_1T), DM, NP, e, c.G == 256 ? 64 : 0); }
        GSYNC(); }
#if PROBE_MODE == 1
        { const Ctx c = fresh(c0); phase_p2<true, false, true>(c, l, 1); }
        GSYNC();
#elif PROBE_MODE == 2
        { const Ctx c = fresh(c0); phase_p2<true, true, false>(c, l, 1); }
        GSYNC();
#endif
        { const Ctx c = fresh(c0); phase_p2<false, true, true>(c, l, 0); }
        GSYNC();
        for (int rep = 0; rep < ((PROBE_MODE == 4) ? 2 : 1); ++rep) {
        { const Ctx c = fresh(c0);
          pg8::PlainSched S{(const char*)c.XN(), (const char*)(c.ws + W_MT), (size_t)256 * DM * 2, (size_t)256 * DM * 2, 3072 / 256, c.G, (int)blockIdx.x};
          pg8::EpiGran<EpiSig, true> et{EpiSig{c.P()}}; pg8::gemm_phase<pg8::EpiGran<EpiSig, true>, pg8::PlainSched, true>(c.lds, DM, DM, DM, S, et); }
        { const Ctx c = fresh(c0); EpiSig e{c.P()}; phase_ngemm(c, c.XN(), DM, RG_REAL, RG_ALL, (const u16*)(c.ws + W_MT), DM, 3072, e); }
        GSYNC();
        { const Ctx c = fresh(c0); MergeSched S{(const char*)c.P(), (const char*)(c.ws + W_BR), c.G, (int)blockIdx.x};
          EpiMergeTile et{c.P(), c.XN()}; pg8::gemm_phase<EpiMergeTile, MergeSched, true>(c.lds, NP, 512, 512, S, et); }
        { const Ctx c = fresh(c0); phase_p3b_naive(c, RG_REAL, RG_ALL); }
        GSYNC();
        { const Ctx c = fresh(c0);
          pg8::PlainSched S{(const char*)c.XN(), (const char*)(c.ws + W_OUT), (size_t)256 * DM * 2, (size_t)256 * DM * 2, DM / 256, c.G, (int)blockIdx.x};
          EpiF32 e{(float*)(c.ws + WS_ARENA)}; pg8::EpiGran<EpiF32, false> et{e}; pg8::gemm_phase<pg8::EpiGran<EpiF32, false>, pg8::PlainSched, false>(c.lds, DM, DM, DM, S, et); }
        { const Ctx c = fresh(c0); EpiF32 e{(float*)(c.ws + WS_ARENA)}; phase_ngemm(c, c.XN(), DM, RG_REAL, RG_ALL, (const u16*)(c.ws + W_OUT), DM, DM, e); }
        GSYNC(); }
        { const Ctx c = fresh(c0);
          for (int r = c.gw; r < MROWS; r += c.NGW)
              row_pass(c.hrow(r), c.hrow(r), (const float*)(c.ws + WS_ARENA) + (size_t)r * DM, c.pp->in[18] + l * DM, c.pp->in[19] + l * DM, c.XN() + (size_t)r * DM, c.lane);
          prep_weights_B(c, l); }
        GSYNC();
        for (int rep = 0; rep < ((PROBE_MODE == 5) ? 2 : 1); ++rep) {
        { const Ctx c = fresh(c0);
          pg8::PlainSched S{(const char*)c.XN(), (const char*)(c.ws + W_GU), (size_t)256 * DM * 2, (size_t)256 * DM * 2, 5632 / 256, c.G, (int)blockIdx.x};
          EpiConvTile et{(u16*)(c.ws + WS_ARENA), c.pp->in[22] + (size_t)l * 3 * DFF, c.pp->in[23] + (size_t)l * DFF, (LAS float*)(c.lds + 131072)};
          pg8::gemm_phase<EpiConvTile, pg8::PlainSched, true>(c.lds, DM, DM, DM, S, et); }
        { const Ctx c = fresh(c0); phase_p5_naive<0>(c, l, RG_REAL, RG_ALL, c.G == 256 ? 128 : 0); }
        { const Ctx c = fresh(c0); phase_p5_naive<1>(c, l, 0, 8, c.G == 256 ? 128 : 0); }
        GSYNC();
        { const Ctx c = fresh(c0);
          pg8::PlainSched S{(const char*)(c.ws + WS_ARENA), (const char*)(c.ws + W_DN), (size_t)256 * DFF * 2, (size_t)256 * DFF * 2, DM / 256, c.G, (int)blockIdx.x};
          EpiF32 e{(float*)(c.ws + WS_ARENA + AR_Z)}; pg8::EpiGran<EpiF32, false> et{e}; pg8::gemm_phase<pg8::EpiGran<EpiF32, false>, pg8::PlainSched, false>(c.lds, DFF, DFF, DFF, S, et); }
        { const Ctx c = fresh(c0); EpiF32 e{(float*)(c.ws + WS_ARENA + AR_Z)}; phase_ngemm(c, (const u16*)(c.ws + WS_ARENA), DFF, RG_REAL, RG_ALL, (const u16*)(c.ws + W_DN), DFF, DM, e); }
        GSYNC(); }
        { const Ctx c = fresh(c0);
          for (int r = c.gw; r < MROWS; r += c.NGW)
              row_pass(c.hrow(r), c.hrow(r), (const float*)(c.ws + WS_ARENA + AR_Z) + (size_t)r * DM, c.pp->in[25] + l * DM, l + 1 < DEPTH ? c.pp->in[3] + (l + 1) * DM : nullptr, l + 1 < DEPTH ? c.XN() + (size_t)r * DM : nullptr, c.lane);
          if (l + 1 < DEPTH) prep_weights_A(c, l + 1); }
        if (l + 1 < DEPTH) GSYNC();
    }
}

extern "C" void kernel_launch(void* const* d_in, const int* in_sizes, int n_in, void* d_out, int out_size, void* d_ws, size_t ws_size, hipStream_t stream) {
    static int grid = 0;
    if (grid == 0) {
        if (n_in != 26 || out_size != MREAL * DM || ws_size < WS_END) { fprintf(stderr, "kernel_launch: unexpected shapes n_in %d out %d ws %zu (need %zu)\n", n_in, out_size, ws_size, (size_t)WS_END); grid = -1; return; }
        int dev = 0, cus = 0, per_cu = 0;
        hipGetDevice(&dev); hipDeviceGetAttribute(&cus, hipDeviceAttributeMultiprocessorCount, dev);
        hipFuncSetAttribute((const void*)mega_fwd, hipFuncAttributeMaxDynamicSharedMemorySize, LDS_BYTES);
        hipOccupancyMaxActiveBlocksPerMultiprocessor(&per_cu, (const void*)mega_fwd, 512, LDS_BYTES);
        if (per_cu < 1) { fprintf(stderr, "kernel_launch: occupancy query says %d\n", per_cu); per_cu = 1; }
        grid = cus * 1;
        (void)hipGetLastError();
    }
    if (grid < 0) return;
    hipMemsetAsync((char*)d_ws + WS_CTL, 0, 64 * 1024, stream);
    Params p{};
    for (int i = 0; i < 26; ++i) p.in[i] = (const float*)d_in[i];
    p.out = (float*)d_out; p.ws = (unsigned char*)d_ws;
    void* args[] = {&p};
    hipError_t e = hipLaunchCooperativeKernel((const void*)mega_fwd, dim3(grid), dim3(512), args, LDS_BYTES, stream);
    if (e != hipSuccess) fprintf(stderr, "cooperative launch failed: %s (grid %d)\n", hipGetErrorString(e), grid);
}
```

```cpp
#include <hip/hip_runtime.h>
#include <hip/hip_cooperative_groups.h>
#include <cstdio>
#include <cstdint>
namespace cg = cooperative_groups;

#define LAS __attribute__((address_space(3)))
typedef unsigned short u16;
typedef short bf16x8 __attribute__((ext_vector_type(8)));
typedef float f32x4 __attribute__((ext_vector_type(4)));
typedef unsigned u32x2 __attribute__((ext_vector_type(2)));
typedef unsigned u32x4 __attribute__((ext_vector_type(4)));

constexpr int NB = 2, TS = 8192, NMETA = 16, LSEQ = TS + NMETA, DM = 1024, DEPTH = 2;
constexpr int MREAL = NB * TS;
constexpr int MROWS = MREAL + NB * NMETA;
constexpr int DIN = 8208, DFF = 2816;
constexpr int NP = 5376;
constexpr float EPS = 1e-6f;
constexpr float LOG2E = 1.4426950408889634f;
constexpr int C_HQ = 0, C_HF = 512, C_HG = 1024, C_GG = 1536, C_DK = 2048, C_DV = 2560, C_GQ = 3072, C_GK = 3328, C_GL = 3584, C_HI = 3840, C_GV = 4352, C_DQ = 4864;
constexpr int S_HQ = 0, S_HF = 512, S_HI = 1024, S_HG = 1536, S_GQ = 2048, S_GK = 2304, S_GV = 2560, S_GG = 3072, S_GLR = 3584, S_DQ = 3600, S_DK = 4112, S_DV = 4624, S_M = 5136;

constexpr size_t MiB = 1u << 20;
constexpr size_t WS_CTL = 0;
constexpr size_t WS_LB = 64 * 1024;
constexpr size_t WS_LAM = 72 * 1024;
constexpr size_t WS_KMAX = 40960;
constexpr size_t WS_HM = 128 * 1024;
constexpr size_t WS_WTS = 2 * MiB;
constexpr size_t W_1T = WS_WTS;
constexpr size_t W_MT = W_1T + (size_t)NP * DM * 2;
constexpr size_t W_BR = W_MT + (size_t)3072 * DM * 2;
constexpr size_t W_OUT = W_BR + (size_t)3 * 1024 * 512 * 2;
constexpr size_t W_GU = WS_WTS;
constexpr size_t W_DN = W_GU + (size_t)5632 * DM * 2;
static_assert(W_DN + (size_t)DM * DFF * 2 <= W_BR, "ffn weights must not clobber Wbr/Wout");
constexpr size_t WS_XN = 24 * MiB;
constexpr size_t WS_SCAN = 57 * MiB;
constexpr size_t WS_ARENA = 83 * MiB;
constexpr size_t AR_Z = 96 * MiB;
static_assert(W_OUT + (size_t)DM * DM * 2 <= WS_XN, "weights region");
static_assert(WS_XN + (size_t)MROWS * DM * 2 <= WS_SCAN, "xn region");
constexpr size_t WS_END = WS_ARENA + (size_t)MROWS * NP * 2;
static_assert(WS_END <= 268435456, "ws budget");
static_assert((size_t)MROWS * DFF * 2 <= AR_Z && AR_Z + (size_t)MROWS * DM * 4 <= (size_t)MROWS * NP * 2, "arena overlay");

constexpr int LDS_BYTES = 147456;

struct Params { const float* in[26]; float* out; unsigned char* ws; };

__device__ __forceinline__ float bf2f(u16 x) { return __uint_as_float((unsigned)x << 16); }
__device__ __forceinline__ unsigned f2bf(float f) { unsigned u = __builtin_bit_cast(unsigned, f); return (u + 0x7fffu + ((u >> 16) & 1u)) >> 16; }
__device__ __forceinline__ unsigned pk2(float lo, float hi) { return f2bf(lo) | (f2bf(hi) << 16); }
__device__ __forceinline__ u16 f2h(float f) { return __builtin_bit_cast(u16, (_Float16)f); }
__device__ __forceinline__ float h2f(u16 x) { return (float)__builtin_bit_cast(_Float16, x); }
__device__ __forceinline__ float sigmoid_f(float x) { return 1.f / (1.f + __expf(-x)); }
__device__ __forceinline__ float silu_f(float x) { return x / (1.f + __expf(-x)); }
__device__ __forceinline__ float logsigmoid_f(float x) { return fminf(x, 0.f) - log1pf(__expf(-fabsf(x))); }
__device__ __forceinline__ float gelu_tanh_f(float x) { const float u = 0.7978845608028654f * (x + 0.044715f * x * x * x); const float t = 1.f - 2.f / (__expf(2.f * u) + 1.f); return 0.5f * x * (1.f + t); }
__device__ __forceinline__ float wave_sum(float v) {
#pragma unroll
    for (int o = 1; o < 64; o <<= 1) v += __shfl_xor(v, o);
    return v;
}
__device__ __forceinline__ int row_of(int b, int p) { return p < NMETA ? MREAL + b * NMETA + p : b * TS + (p - NMETA); }
__device__ __forceinline__ int prev_row(int r) {
    if (r < 0) return -1;
    if (r >= MREAL) { const int i = (r - MREAL) & 15; return i ? r - 1 : -1; }
    const int t = r & (TS - 1); if (t) return r - 1; return MREAL + (r >> 13) * NMETA + 15;
}

struct Ctx {
    const Params* pp; float* out; unsigned char* ws;
    int tid, lane, wave, G, gw, NGW;
    LAS unsigned char* lds;
    __device__ __forceinline__ float* hrow(int r) const { return r < MREAL ? out + (size_t)r * DM : (float*)(ws + WS_HM) + (size_t)(r - MREAL) * DM; }
    __device__ __forceinline__ u16* P() const { return (u16*)(ws + WS_ARENA); }
    __device__ __forceinline__ u16* XN() const { return (u16*)(ws + WS_XN); }
};

__device__ __forceinline__ Ctx fresh(const Ctx& c0) {
    Ctx c = c0;
    asm volatile("" : "+v"(c.tid));
    asm volatile("" : "+s"(c.wave), "+s"(c.G));
    asm volatile("" : "+s"(c.ws), "+s"(c.out));
    c.lane = c.tid & 63; c.gw = blockIdx.x * 8 + c.wave; c.NGW = c.G * 8;
    return c;
}
#define XB_TMO      128
#define XB_XCNT(j)  (256  + 64 * (j))
#define XB_XSUB(j)  (1280 + 64 * (j))
#define XB_XGEN(j)  (2304 + 64 * (j))
#define XB_TOP      3328
#define XB_TOPGEN   3392
#define XCD_BAR_WORDS 3456
#define XB_SPIN_CAP (1u << 20)
__device__ __forceinline__ unsigned xb_ld(unsigned* p)              { return __hip_atomic_load(p, __ATOMIC_RELAXED, __HIP_MEMORY_SCOPE_AGENT); }
__device__ __forceinline__ unsigned xb_add(unsigned* p, unsigned v) { return __hip_atomic_fetch_add(p, v, __ATOMIC_RELAXED, __HIP_MEMORY_SCOPE_AGENT); }
__device__ __forceinline__ unsigned xb_xcc_id() { return (unsigned)__builtin_amdgcn_s_getreg((3 << 11) | 20) & 0xFu; }
#define XB_SPIN(cond, bar) do { unsigned _sp = 0; while (cond) { __builtin_amdgcn_s_sleep(1); \
    if ((++_sp & 255u) == 0u) { if (xb_ld(&(bar)[XB_TMO])) break; if (_sp > XB_SPIN_CAP) { atomicAdd(&(bar)[XB_TMO], 1u); break; } } } } while (0)
struct XcdBarrier { unsigned* bar; unsigned x; volatile LAS unsigned* st; };
__device__ __forceinline__ XcdBarrier xcd_barrier_post(unsigned* bar, volatile LAS unsigned* st) {
    XcdBarrier b; b.bar = bar; b.x = xb_xcc_id(); b.st = st;
    if (threadIdx.x == 0) (void)xb_add(&bar[XB_XCNT(b.x)], 1u);
    return b;
}
__device__ __forceinline__ void xcd_barrier_complete(unsigned* bar, unsigned x, unsigned& nloc, unsigned& nx) {
    const unsigned G = gridDim.x * gridDim.y * gridDim.z;
    unsigned sum, cnt, mine, sp = 0u;
    for (;;) {
        sum = 0u; cnt = 0u; mine = 0u;
#pragma unroll
        for (unsigned j = 0; j < 16; ++j) { const unsigned c = xb_ld(&bar[XB_XCNT(j)]); sum += c; cnt += (c > 0u) ? 1u : 0u; mine = (j == x) ? c : mine; }
        if (sum == G) break;
        __builtin_amdgcn_s_sleep(1);
        if ((++sp & 255u) == 0u) { if (xb_ld(&bar[XB_TMO])) break; if (sp > XB_SPIN_CAP) { atomicAdd(&bar[XB_TMO], 1u); break; } }
    }
    nloc = mine > 0u ? mine : 1u; nx = cnt > 0u ? cnt : 1u;
}
__device__ __forceinline__ void xcd_barrier(const XcdBarrier& b) {
    asm volatile("s_waitcnt vmcnt(0)" ::: "memory");
    __syncthreads();
    if (threadIdx.x == 0) {
        unsigned* bar = b.bar;
        __builtin_amdgcn_s_waitcnt(0);
        unsigned nloc = b.st[0], nx = b.st[1];
        if (nloc == 0u) { xcd_barrier_complete(bar, b.x, nloc, nx); b.st[0] = nloc; b.st[1] = nx; }
        const unsigned old = xb_add(&bar[XB_XSUB(b.x)], 1u);
        const unsigned gen = old / nloc;
        if (old + 1u == (gen + 1u) * nloc) {
            __builtin_amdgcn_fence(__ATOMIC_RELEASE, "agent");
            asm volatile("s_waitcnt vmcnt(0)" ::: "memory");
            const unsigned og = xb_add(&bar[XB_TOP], 1u);
            const unsigned tg = og / nx;
            if (og + 1u == (tg + 1u) * nx) xb_add(&bar[XB_TOPGEN], 1u);
            else XB_SPIN(xb_ld(&bar[XB_TOPGEN]) == tg, bar);
            __builtin_amdgcn_fence(__ATOMIC_ACQUIRE, "agent");
            xb_add(&bar[XB_XGEN(b.x)], 1u);
            asm volatile("s_waitcnt vmcnt(0)" ::: "memory");
        } else {
            XB_SPIN(xb_ld(&bar[XB_XGEN(b.x)]) == gen, bar);
            __builtin_amdgcn_fence(__ATOMIC_ACQUIRE, "agent");
            asm volatile("s_waitcnt vmcnt(0)" ::: "memory");
        }
    }
    __syncthreads();
}
__device__ __forceinline__ void tr_item(const float* src, int ld, int scol0, u16* dst, int K, int n0, int k0, LAS float* scr, int lane) {
#pragma unroll 8
    for (int i = 0; i < 32; ++i) { const int kk = 2 * i + (lane >> 5); scr[kk * 33 + (lane & 31)] = src[(size_t)(k0 + kk) * ld + scol0 + (lane & 31)]; }
    asm volatile("s_waitcnt lgkmcnt(0)" ::: "memory");
    const int c = lane & 7;
#pragma unroll
    for (int j = 0; j < 4; ++j) { const int n = (lane >> 3) + 8 * j; const LAS float* s = scr + (8 * c) * 33 + n;
        u32x4 o; o.x = pk2(s[0 * 33], s[1 * 33]); o.y = pk2(s[2 * 33], s[3 * 33]); o.z = pk2(s[4 * 33], s[5 * 33]); o.w = pk2(s[6 * 33], s[7 * 33]);
        *(u32x4*)(dst + (size_t)(n0 + n) * K + k0 + 8 * c) = o; }
    asm volatile("s_waitcnt lgkmcnt(0)" ::: "memory");
}
__device__ __forceinline__ int p1_srccol(int c) {
    if (c < 512) return S_HQ + c;
    if (c < 1024) return S_HF + (c - 512);
    if (c < 1536) return S_HG + (c - 1024);
    if (c < 2048) return S_GG + (c - 1536);
    if (c < 2560) return S_DK + (c - 2048);
    if (c < 3072) return S_DV + (c - 2560);
    if (c < 3328) return S_GQ + (c - 3072);
    if (c < 3584) return S_GK + (c - 3328);
    if (c < 3840) return -1;
    if (c < 4352) return S_HI + (c - 3840);
    if (c < 4864) return S_GV + (c - 4352);
    return S_DQ + (c - 4864);
}
__device__ __forceinline__ void prep_weights_A(const Ctx& c, int l) {
    LAS float* scr = (LAS float*)(c.lds + c.wave * 8448);
    const float* w_in = c.pp->in[4] + (size_t)l * DM * DIN;
    constexpr int I1 = (NP / 32) * 16, I2 = (3072 / 32) * 16, I3 = 3 * 32 * 8, I4 = 32 * 16;
    for (int it = c.gw; it < I1 + I2 + I3 + I4; it += c.NGW) {
        int r = it;
        if (r < I1) { const int nb = r / 16, kb = r % 16; const int sc = p1_srccol(nb * 32); if (sc >= 0) tr_item(w_in, DIN, sc, (u16*)(c.ws + W_1T), DM, nb * 32, kb * 64, scr, c.lane); continue; } r -= I1;
        if (r < I2) { const int nb = r / 16, kb = r % 16; tr_item(w_in, DIN, S_M + nb * 32, (u16*)(c.ws + W_MT), DM, nb * 32, kb * 64, scr, c.lane); continue; } r -= I2;
        if (r < I3) { const int br = r / 256, q = r % 256, nb = q / 8, kb = q % 8; const float* src = c.pp->in[14 + br] + (size_t)l * 512 * DM;
            tr_item(src, DM, nb * 32, (u16*)(c.ws + W_BR) + (size_t)br * 1024 * 512, 512, nb * 32, kb * 64, scr, c.lane); continue; } r -= I3;
        { const int nb = r / 16, kb = r % 16; tr_item(c.pp->in[17] + (size_t)l * DM * DM, DM, nb * 32, (u16*)(c.ws + W_OUT), DM, nb * 32, kb * 64, scr, c.lane); }
    }
    const float* gup = c.pp->in[6] + (size_t)l * 16 * 256;
    for (int id = c.gw * 64 + c.lane; id < 256 * DM; id += c.NGW * 64) {
        const int k = id & (DM - 1), j = id >> 10; float s = 0.f;
#pragma unroll
        for (int r = 0; r < 16; ++r) s += w_in[(size_t)k * DIN + S_GLR + r] * gup[r * 256 + j];
        ((u16*)(c.ws + W_1T))[(size_t)(C_GL + j) * DM + k] = (u16)f2bf(s);
    }
}
__device__ __forceinline__ void prep_weights_B(const Ctx& c, int l) {
    LAS float* scr = (LAS float*)(c.lds + c.wave * 8448);
    constexpr int I1 = (5632 / 32) * 16, I2 = 32 * 44;
    for (int it = c.gw; it < I1 + I2; it += c.NGW) {
        int r = it;
        if (r < I1) { const int nb = r / 16, kb = r % 16, n0 = nb * 32, j = n0 >> 8, half = (n0 >> 7) & 1, c0 = n0 & 127;
            const float* src = c.pp->in[half ? 21 : 20] + (size_t)l * DM * DFF; tr_item(src, DFF, 128 * j + c0, (u16*)(c.ws + W_GU), DM, n0, kb * 64, scr, c.lane); continue; } r -= I1;
        { const int nb = r / 44, kb = r % 44; tr_item(c.pp->in[24] + (size_t)l * DFF * DM, DM, nb * 32, (u16*)(c.ws + W_DN), DFF, nb * 32, kb * 64, scr, c.lane); }
    }
}
__device__ __forceinline__ void prep_misc(const Ctx& c) {
    if (blockIdx.x == 0) {
        float* LB = (float*)(c.ws + WS_LB); const float* lbp = c.pp->in[2];
        for (int i = c.tid; i < 512; i += 512) { const float a = lbp[i], b = lbp[512 + i], m = fmaxf(a, b), ea = __expf(a - m), eb = __expf(b - m); LB[i] = 0.f; LB[512 + i] = eb / (ea + eb); }
        if (c.wave == 0) {
            for (int l = 0; l < DEPTH; ++l) {
                float s1 = c.pp->in[9][l * 64 + c.lane] * c.pp->in[10][l * 64 + c.lane], s2 = c.pp->in[11][l * 64 + c.lane] * c.pp->in[12][l * 64 + c.lane];
                s1 = wave_sum(s1); s2 = wave_sum(s2);
                const float linit = 0.8f - 0.6f * expf(-0.3f * (float)l);
                if (c.lane == 0) ((float*)(c.ws + WS_LAM))[l] = expf(s1) - expf(s2) + linit;
            }
        }
    }
}

__device__ __forceinline__ void row_pass(const float* src_h, float* dst_h, const float* y, const float* w_post, const float* w_next, u16* xn_row, int lane) {
    f32x4 hv[4];
#pragma unroll
    for (int j = 0; j < 4; ++j) hv[j] = ((const f32x4*)src_h)[lane + 64 * j];
    if (y) {
        f32x4 yv[4]; float ss = 0.f;
#pragma unroll
        for (int j = 0; j < 4; ++j) { yv[j] = ((const f32x4*)y)[lane + 64 * j]; ss += (yv[j].x * yv[j].x + yv[j].y * yv[j].y) + (yv[j].z * yv[j].z + yv[j].w * yv[j].w); }
        const float r = rsqrtf(wave_sum(ss) * (1.f / DM) + EPS);
#pragma unroll
        for (int j = 0; j < 4; ++j) { const f32x4 w = ((const f32x4*)w_post)[lane + 64 * j]; hv[j] = hv[j] + yv[j] * r * w; }
    }
    if (dst_h) {
#pragma unroll
        for (int j = 0; j < 4; ++j) ((f32x4*)dst_h)[lane + 64 * j] = hv[j];
    }
    if (xn_row) {
        float ss = 0.f;
#pragma unroll
        for (int j = 0; j < 4; ++j) ss += (hv[j].x * hv[j].x + hv[j].y * hv[j].y) + (hv[j].z * hv[j].z + hv[j].w * hv[j].w);
        const float r = rsqrtf(wave_sum(ss) * (1.f / DM) + EPS);
#pragma unroll
        for (int j = 0; j < 4; ++j) { const f32x4 w = ((const f32x4*)w_next)[lane + 64 * j]; const f32x4 o = hv[j] * r * w;
            u32x2 pk; pk.x = pk2(o.x, o.y); pk.y = pk2(o.z, o.w); ((u32x2*)xn_row)[lane + 64 * j] = pk; }
    }
}

template <int NT> __device__ __forceinline__ void wgemm16(const u16* ap  , bool avalid, const u16* bp  , size_t bstride  , int K, f32x4 (&acc)[NT]) {
    const bf16x8 z = {0, 0, 0, 0, 0, 0, 0, 0};
#pragma unroll 8
    for (int k0 = 0; k0 < K; k0 += 32) {
        bf16x8 a = *(const bf16x8*)(ap + k0); a = avalid ? a : z;
#pragma unroll
        for (int nt = 0; nt < NT; ++nt) { const bf16x8 b = *(const bf16x8*)(bp + nt * bstride + k0); acc[nt] = __builtin_amdgcn_mfma_f32_16x16x32_bf16(b, a, acc[nt], 0, 0, 0); }
    }
}
template <class Epi> __device__ __forceinline__ void phase_ngemm(const Ctx& c, const u16* A, int lda, int rg0, int rg1, const u16* Bt, int K, int N, const Epi& epi, int fb = 0) {
    const int ncg = N / 64, nu = (rg1 - rg0) * ncg, fr = c.lane & 15, fq = c.lane >> 4;
    if ((int)blockIdx.x < fb) return;
    for (int u = c.gw - fb * 8; u < nu; u += c.NGW - fb * 8) {
        const int rg = rg0 + u / ncg, cgi = u % ncg, row = rg * 16 + fr;
        f32x4 acc[4];
#pragma unroll
        for (int i = 0; i < 4; ++i) acc[i] = (f32x4){0.f, 0.f, 0.f, 0.f};
        wgemm16<4>(A + (size_t)row * lda + 8 * fq, true, Bt + (size_t)(cgi * 64 + fr) * K + 8 * fq, (size_t)16 * K, K, acc);
#pragma unroll
        for (int nt = 0; nt < 4; ++nt) epi(row, cgi * 64 + nt * 16 + 4 * fq, acc[nt]);
    }
}

__device__ __forceinline__ void store4_bf16(u16* p, f32x4 v) { u32x2 o; o.x = pk2(v.x, v.y); o.y = pk2(v.z, v.w); *(u32x2*)p = o; }
__device__ __forceinline__ void store4_h(u16* p, f32x4 v) { u32x2 o; o.x = (unsigned)f2h(v.x) | ((unsigned)f2h(v.y) << 16); o.y = (unsigned)f2h(v.z) | ((unsigned)f2h(v.w) << 16); *(u32x2*)p = o; }
struct EpiP1 {
    u16* P; const float* LB; const float* gbias; unsigned* kmax;
    __device__ __forceinline__ void operator()(int row, int col, f32x4 v) const {
        u16* dst = P + (size_t)row * NP + col;
        if (col < 512) { f32x4 o; o.x = silu_f(v.x); o.y = silu_f(v.y); o.z = silu_f(v.z); o.w = silu_f(v.w); store4_bf16(dst, o); }
        else if (col < 1024) { const f32x4 lb = *(const f32x4*)(LB + col - 512); f32x4 o;
            o.x = LOG2E * __logf(lb.x + (1.f - lb.x) * sigmoid_f(v.x)); o.y = LOG2E * __logf(lb.y + (1.f - lb.y) * sigmoid_f(v.y)); o.z = LOG2E * __logf(lb.z + (1.f - lb.z) * sigmoid_f(v.z)); o.w = LOG2E * __logf(lb.w + (1.f - lb.w) * sigmoid_f(v.w));
            store4_h(dst, o); }
        else if (col < 2048) { f32x4 o; o.x = silu_f(v.x); o.y = silu_f(v.y); o.z = silu_f(v.z); o.w = silu_f(v.w); store4_bf16(dst, o); }
        else if (col < 3072) { store4_bf16(dst, v);
            if (col < 2560) { const float mx = fmaxf(fmaxf(fabsf(v.x), fabsf(v.y)), fmaxf(fabsf(v.z), fabsf(v.w))); atomicMax(kmax + ((col - 2048) >> 7), __float_as_uint(mx)); } }
        else if (col < 3328) store4_bf16(dst, v * 0.125f);
        else if (col < 3584) store4_bf16(dst, v);
        else if (col < 3840) { const f32x4 bb = *(const f32x4*)(gbias + col - 3584); f32x4 o;
            o.x = logsigmoid_f(v.x + bb.x) * (0.0625f * LOG2E); o.y = logsigmoid_f(v.y + bb.y) * (0.0625f * LOG2E); o.z = logsigmoid_f(v.z + bb.z) * (0.0625f * LOG2E); o.w = logsigmoid_f(v.w + bb.w) * (0.0625f * LOG2E);
            store4_h(dst, o); }
        else if (col < 4864) store4_bf16(dst, v);
        else store4_bf16(dst, v * (0.125f * LOG2E));
    }
};
struct EpiSig {
    u16* P;
    __device__ __forceinline__ void operator()(int row, int col, f32x4 v) const { f32x4 o; o.x = sigmoid_f(v.x); o.y = sigmoid_f(v.y); o.z = sigmoid_f(v.z); o.w = sigmoid_f(v.w); store4_bf16(P + (size_t)row * NP + col, o); }
};
struct EpiF32 { float* Y; __device__ __forceinline__ void operator()(int row, int col, f32x4 v) const { *(f32x4*)(Y + (size_t)row * DM + col) = v; } };


namespace pg8 {
constexpr int BM = 256, BK = 64, HALF = 128, HTB = HALF * BK * 2, STAGE_BYTES = 8 * HTB, NXCD = 8, WGM = 8;
__host__ __device__ __forceinline__ int lds_byte(int r, int c) { const int st = (r >> 4) * 2 + (c >> 5), rr = r & 15, cc = c & 31, ob = rr * 64 + cc * 2; return st * 1024 + (ob ^ (((ob >> 9) & 1) << 5)); }
__host__ __device__ __forceinline__ void stage_rc(int b, int& R, int& C) { const int st = b / 1024, sb = b % 1024, swz = sb ^ (((sb >> 9) & 1) << 5); R = (st >> 1) * 16 + swz / 64; C = (st & 1) * 32 + (swz % 64) / 2; }
__host__ __device__ __forceinline__ int perm32(int rho) { const int n = rho >> 4, i = rho & 15; return 8 * (i >> 2) + 4 * n + (i & 3); }
struct Unit { int pm, pn, z; const char* A; const char* B; };
__device__ __forceinline__ bool static_tile(int i, int G, int c, int nM, int nN, int& pm, int& pn) {
    const int nwg = nM * nN; const long L = (long)i * G + c; if (L >= nwg) return false;
    int wgid = (int)L; { const int q = nwg / NXCD, r = nwg % NXCD, xcd = wgid % NXCD, off = wgid / NXCD; wgid = (xcd < r ? xcd * (q + 1) : r * (q + 1) + (xcd - r) * q) + off; }
    const int nig = WGM * nN, gid = wgid / nig, fm = gid * WGM, gsz = (nM - fm) < WGM ? (nM - fm) : WGM;
    pm = fm + ((wgid % nig) % gsz); pn = (wgid % nig) / gsz; return true;
}
template <class Epi, class Sched, bool ALIGN_EPI>
__device__ __forceinline__ void gemm_phase(LAS unsigned char* lds, const int lda, const int ldb, const int K, const Sched& S, const Epi& E) {
    int tid_ = threadIdx.x; asm volatile("" : "+v"(tid_));
    const int tid = tid_, wid = __builtin_amdgcn_readfirstlane(tid >> 6), lane = tid & 63, wr = wid >> 2, wc = wid & 3, fr = lane & 15, fq = lane >> 4;
    const int nt = K / BK;
    unsigned voffA[2], voffB[2];
#pragma unroll
    for (int i = 0; i < 2; ++i) { int R, C; stage_rc(tid * 16 + i * 8192, R, C); const int Rb = Epi::PERM ? ((R & ~31) + perm32(R & 31)) : R;
        voffA[i] = (unsigned)(R * lda + C) * 2u; voffB[i] = (unsigned)(Rb * ldb + C) * 2u; }
    const size_t kstep = (size_t)(BK * 2);
    const size_t hstepA = (size_t)HALF * lda * 2, hstepB = (size_t)HALF * ldb * 2;
    const unsigned ldsw = (unsigned)wid * 1024u;
    const int aoff = lds_byte(wr * 64 + fr, fq * 8), boff = lds_byte(wc * 32 + fr, fq * 8);
#define PG8_SA(b, h) (((b) * 2 + (h)) * HTB)
#define PG8_SB(b, h) ((4 + (b) * 2 + (h)) * HTB)
#define PG8_STAGE(bufoff, gbase, voff) do { _Pragma("unroll") for (int _i = 0; _i < 2; ++_i) \
        __builtin_amdgcn_global_load_lds((const unsigned*)((const char*)(gbase) + (voff)[_i]), (LAS unsigned*)(lds + (bufoff) + ldsw + _i * 8192), 16, 0, 0); } while (0)
#define PG8_LDA(dst, b, h) do { _Pragma("unroll") for (int m = 0; m < 4; ++m) _Pragma("unroll") for (int k = 0; k < 2; ++k) dst[m][k] = *(const LAS bf16x8*)(lds + PG8_SA(b, h) + aoff + m * 2048 + k * 1024); } while (0)
#define PG8_LDB(dst, b, h) do { _Pragma("unroll") for (int n = 0; n < 2; ++n) _Pragma("unroll") for (int k = 0; k < 2; ++k) dst[n][k] = *(const LAS bf16x8*)(lds + PG8_SB(b, h) + boff + n * 2048 + k * 1024); } while (0)
#define PG8_MMA(ai, bj, At, Bt) do { __builtin_amdgcn_s_setprio(1); _Pragma("unroll") for (int m = 0; m < 4; ++m) _Pragma("unroll") for (int n = 0; n < 2; ++n) _Pragma("unroll") for (int k = 0; k < 2; ++k) \
        acc[ai][bj][m][n] = __builtin_amdgcn_mfma_f32_16x16x32_bf16(Bt[n][k], At[m][k], acc[ai][bj][m][n], 0, 0, 0); __builtin_amdgcn_s_setprio(0); } while (0)
#define PG8_WAIT_V(n) asm volatile("s_waitcnt vmcnt(" #n ")" ::: "memory")
#define PG8_WAIT_L(n) asm volatile("s_waitcnt lgkmcnt(" #n ")" ::: "memory")
#define PG8_BAR __builtin_amdgcn_s_barrier()
#define PG8_SCHED __builtin_amdgcn_sched_barrier(0)
    Unit cur, nxt; int ui = 0;
    if (!S.next(0, cur)) return;
    f32x4 acc[2][2][4][2];
#pragma unroll
    for (int a = 0; a < 2; ++a)
#pragma unroll
        for (int b = 0; b < 2; ++b)
#pragma unroll
            for (int m = 0; m < 4; ++m)
#pragma unroll
                for (int n = 0; n < 2; ++n) acc[a][b][m][n] = (f32x4){0.f, 0.f, 0.f, 0.f};
    bf16x8 At[4][2], B0[2][2], B1[2][2];
    const char* cA = cur.A; const char* cB = cur.B;
    PG8_STAGE(PG8_SB(0, 0), cB, voffB); PG8_STAGE(PG8_SB(0, 1), cB + hstepB, voffB); PG8_STAGE(PG8_SA(0, 0), cA, voffA); PG8_STAGE(PG8_SA(0, 1), cA + hstepA, voffA);
    if (wr == 1) PG8_BAR;
    PG8_WAIT_V(2); PG8_BAR;
    PG8_STAGE(PG8_SB(1, 0), cB + kstep, voffB); PG8_STAGE(PG8_SA(1, 0), cA + kstep, voffA); PG8_STAGE(PG8_SB(1, 1), cB + hstepB + kstep, voffB);
    PG8_WAIT_V(6); PG8_BAR;
    for (;;) {
        const bool has_next = S.next(ui + 1, nxt);
        const char* nA = has_next ? nxt.A : cA; const char* nB = has_next ? nxt.B : cB;
        for (int t = 0; t < nt; t += 2) {
            const bool last = (t == nt - 2);
            const char* a1 = cA + (size_t)(t + 1) * kstep;
            const char* a2 = last ? nA : cA + (size_t)(t + 2) * kstep; const char* b2 = last ? nB : cB + (size_t)(t + 2) * kstep;
            const char* a3 = a2 + kstep; const char* b3 = b2 + kstep;
            PG8_LDB(B0, 0, 0); PG8_LDB(B1, 0, 1); PG8_SCHED; PG8_LDA(At, 0, 0); PG8_STAGE(PG8_SA(1, 1), a1 + hstepA, voffA);
            PG8_WAIT_V(8); PG8_WAIT_L(0); PG8_BAR; PG8_MMA(0, 0, At, B0); PG8_MMA(0, 1, At, B1); PG8_BAR; PG8_SCHED;
            PG8_LDA(At, 0, 1); PG8_STAGE(PG8_SB(0, 0), b2, voffB); PG8_STAGE(PG8_SB(0, 1), b2 + hstepB, voffB); PG8_STAGE(PG8_SA(0, 0), a2, voffA);
            PG8_WAIT_V(8); PG8_WAIT_L(0); PG8_BAR; PG8_MMA(1, 0, At, B0); PG8_MMA(1, 1, At, B1); PG8_BAR; PG8_SCHED;
            PG8_LDB(B0, 1, 0); PG8_LDB(B1, 1, 1); PG8_SCHED; PG8_LDA(At, 1, 0); PG8_STAGE(PG8_SA(0, 1), a2 + hstepA, voffA);
            PG8_WAIT_V(8); PG8_WAIT_L(0); PG8_BAR; PG8_MMA(0, 0, At, B0); PG8_MMA(0, 1, At, B1); PG8_BAR; PG8_SCHED;
            PG8_LDA(At, 1, 1); PG8_STAGE(PG8_SB(1, 0), b3, voffB); PG8_STAGE(PG8_SB(1, 1), b3 + hstepB, voffB); PG8_STAGE(PG8_SA(1, 0), a3, voffA);
            PG8_WAIT_V(8); PG8_WAIT_L(0); PG8_BAR; PG8_MMA(1, 0, At, B0); PG8_MMA(1, 1, At, B1); PG8_BAR; PG8_SCHED;
        }
        if constexpr (ALIGN_EPI) { if (wr == 0) PG8_BAR; }
        E(acc, cur, wr, wc, fr, fq);
        if (!has_next) break;
#pragma unroll
        for (int a = 0; a < 2; ++a)
#pragma unroll
            for (int b = 0; b < 2; ++b)
#pragma unroll
                for (int m = 0; m < 4; ++m)
#pragma unroll
                    for (int n = 0; n < 2; ++n) acc[a][b][m][n] = (f32x4){0.f, 0.f, 0.f, 0.f};
        cur = nxt; cA = nA; cB = nB; ++ui;
        if constexpr (ALIGN_EPI) { if (wr == 1) PG8_BAR; }
    }
    PG8_WAIT_V(0);
    if constexpr (!ALIGN_EPI) { if (wr == 0) PG8_BAR; }
    PG8_BAR;
#undef PG8_SA
#undef PG8_SB
#undef PG8_STAGE
#undef PG8_LDA
#undef PG8_LDB
#undef PG8_MMA
#undef PG8_WAIT_V
#undef PG8_WAIT_L
#undef PG8_BAR
#undef PG8_SCHED
}
struct PlainSched {
    const char* A; const char* Bt; size_t atile, btile; int nN, G, c;
    __device__ __forceinline__ bool next(int i, Unit& u) const { int pm, pn; if (!static_tile(i, G, c, 64, nN, pm, pn)) return false; u.pm = pm; u.pn = pn; u.z = 0; u.A = A + (size_t)pm * atile; u.B = Bt + (size_t)pn * btile; return true; }
};
template <class Gr, bool PERM_> struct EpiGran {
    static constexpr bool PERM = PERM_;
    Gr g;
    __device__ __forceinline__ void operator()(const f32x4 (&acc)[2][2][4][2], const Unit& u, int wr, int wc, int fr, int fq) const {
        int row0 = u.pm * BM + wr * 64 + fr, col0 = u.pn * BM + wc * 32 + (PERM_ ? 8 : 4) * fq;
        asm volatile("" : "+v"(row0), "+v"(col0));
#pragma unroll
        for (int ai = 0; ai < 2; ++ai)
#pragma unroll
            for (int m = 0; m < 4; ++m) { const int row = row0 + ai * HALF + m * 16;
#pragma unroll
                for (int bj = 0; bj < 2; ++bj)
#pragma unroll
                    for (int n = 0; n < 2; ++n) { const int col = col0 + bj * HALF + (PERM_ ? 4 * n : 16 * n); g(row, col, acc[ai][bj][m][n]); } }
    }
};
}

template <int TYPE> __device__ __forceinline__ void p1_gran(u16* dst, int col, f32x4 v, const float* LB, const float* gbias) {
    if (TYPE == 0) { f32x4 o; o.x = silu_f(v.x); o.y = silu_f(v.y); o.z = silu_f(v.z); o.w = silu_f(v.w); store4_bf16(dst, o); }
    else if (TYPE == 1) { const f32x4 lb = *(const f32x4*)(LB + col - 512); f32x4 o;
        o.x = LOG2E * __logf(lb.x + (1.f - lb.x) * sigmoid_f(v.x)); o.y = LOG2E * __logf(lb.y + (1.f - lb.y) * sigmoid_f(v.y)); o.z = LOG2E * __logf(lb.z + (1.f - lb.z) * sigmoid_f(v.z)); o.w = LOG2E * __logf(lb.w + (1.f - lb.w) * sigmoid_f(v.w));
        store4_h(dst, o); }
    else if (TYPE == 2) store4_bf16(dst, v);
    else if (TYPE == 3) store4_bf16(dst, v * 0.125f);
    else if (TYPE == 4) { const f32x4 bb = *(const f32x4*)(gbias + col - 3584); f32x4 o;
        o.x = logsigmoid_f(v.x + bb.x) * (0.0625f * LOG2E); o.y = logsigmoid_f(v.y + bb.y) * (0.0625f * LOG2E); o.z = logsigmoid_f(v.z + bb.z) * (0.0625f * LOG2E); o.w = logsigmoid_f(v.w + bb.w) * (0.0625f * LOG2E);
        store4_h(dst, o); }
    else store4_bf16(dst, v * (0.125f * LOG2E));
}
struct EpiP1Tile {
    static constexpr bool PERM = true;
    u16* P; const float* LB; const float* gbias; unsigned* kmax;
    template <int TYPE> __device__ __forceinline__ void run(const f32x4 (&acc)[2][2][4][2], const pg8::Unit& u, int wr, int wc, int fr, int fq) const {
        int row0 = u.pm * 256 + wr * 64 + fr, col0 = u.pn * 256 + wc * 32 + 8 * fq;
        asm volatile("" : "+v"(row0), "+v"(col0));
#pragma unroll
        for (int ai = 0; ai < 2; ++ai)
#pragma unroll
            for (int m = 0; m < 4; ++m) { const int row = row0 + ai * 128 + m * 16;
#pragma unroll
                for (int bj = 0; bj < 2; ++bj)
#pragma unroll
                    for (int n = 0; n < 2; ++n) { const int col = col0 + bj * 128 + 4 * n; p1_gran<TYPE == 6 ? 2 : TYPE>(P + (size_t)row * NP + col, col, acc[ai][bj][m][n], LB, gbias); } }
        if (TYPE == 6) {
#pragma unroll
            for (int bj = 0; bj < 2; ++bj) { float mx = 0.f;
#pragma unroll
                for (int ai = 0; ai < 2; ++ai)
#pragma unroll
                    for (int m = 0; m < 4; ++m)
#pragma unroll
                        for (int n = 0; n < 2; ++n) { const f32x4 v = acc[ai][bj][m][n]; mx = fmaxf(mx, fmaxf(fmaxf(fabsf(v.x), fabsf(v.y)), fmaxf(fabsf(v.z), fabsf(v.w)))); }
#pragma unroll
                for (int o = 1; o < 64; o <<= 1) mx = fmaxf(mx, __shfl_xor(mx, o));
                if (((fq << 4) | fr) == 0) atomicMax(kmax + (u.pn - 8) * 2 + bj, __float_as_uint(mx)); }
        }
    }
    __device__ __forceinline__ void operator()(const f32x4 (&acc)[2][2][4][2], const pg8::Unit& u, int wr, int wc, int fr, int fq) const {
        const int pn = u.pn;
        if (pn < 2) run<0>(acc, u, wr, wc, fr, fq);
        else if (pn < 4) run<1>(acc, u, wr, wc, fr, fq);
        else if (pn < 8) run<0>(acc, u, wr, wc, fr, fq);
        else if (pn < 10) run<6>(acc, u, wr, wc, fr, fq);
        else if (pn < 12) run<2>(acc, u, wr, wc, fr, fq);
        else if (pn == 12) run<3>(acc, u, wr, wc, fr, fq);
        else if (pn == 13) run<2>(acc, u, wr, wc, fr, fq);
        else if (pn == 14) run<4>(acc, u, wr, wc, fr, fq);
        else if (pn < 19) run<2>(acc, u, wr, wc, fr, fq);
        else run<5>(acc, u, wr, wc, fr, fq);
    }
};

struct EpiConvTile {
    static constexpr bool PERM = true;
    u16* ACT; const float* cw; const float* cb; LAS float* EX;
    __device__ __forceinline__ void operator()(f32x4 (&acc)[2][2][4][2], const pg8::Unit& u, int wr, int wc, int fr, int fq) const {
        int lane = (fq << 4) | fr, chl = wc * 32 + 8 * fq, row0 = u.pm * 256 + wr * 64 + fr;
        asm volatile("" : "+v"(lane), "+v"(chl), "+v"(row0));
        const int frr = lane & 15, src1 = (lane & 48) | ((frr + 15) & 15), src2 = (lane & 48) | ((frr + 14) & 15);
        if (frr >= 14) {
#pragma unroll
            for (int ai = 0; ai < 2; ++ai)
#pragma unroll
                for (int n = 0; n < 2; ++n) *(LAS f32x4*)(EX + ((ai * 2 + wr) * 2 + (frr - 14)) * 128 + chl + 4 * n) = acc[ai][0][3][n];
        }
        asm volatile("s_waitcnt lgkmcnt(0)" ::: "memory"); __builtin_amdgcn_s_barrier(); asm volatile("" ::: "memory");
#pragma unroll
        for (int n = 0; n < 2; ++n) {
            const int ch = u.pn * 128 + chl + 4 * n;
            const f32x4 w0 = *(const f32x4*)(cw + ch), w1 = *(const f32x4*)(cw + DFF + ch), w2 = *(const f32x4*)(cw + 2 * DFF + ch), bb = *(const f32x4*)(cb + ch);
#pragma unroll
            for (int ai = 0; ai < 2; ++ai) {
                const int hg = wr == 1 ? ai * 2 : (ai == 1 ? 1 : -1);
                f32x4 hm1 = (f32x4){0.f, 0.f, 0.f, 0.f}, hm2 = hm1;
                if (hg >= 0 && frr < 2) { hm1 = *(const LAS f32x4*)(EX + (hg * 2 + 1) * 128 + chl + 4 * n); hm2 = *(const LAS f32x4*)(EX + (hg * 2 + 0) * 128 + chl + 4 * n); }
#pragma unroll
                for (int m = 0; m < 4; ++m) {
                    const f32x4 x = acc[ai][0][m][n];
                    f32x4 p1, p2;
#pragma unroll
                    for (int e = 0; e < 4; ++e) {
                        const float a1 = __shfl(x[e], src1), a2 = __shfl(x[e], src2);
                        float b1, b2;
                        if (m > 0) { b1 = __shfl(acc[ai][0][m > 0 ? m - 1 : 0][n][e], src1); b2 = __shfl(acc[ai][0][m > 0 ? m - 1 : 0][n][e], src2); }
                        else { b1 = hm1[e]; b2 = frr == 0 ? hm2[e] : hm1[e]; }
                        p1[e] = frr >= 1 ? a1 : b1; p2[e] = frr >= 2 ? a2 : b2;
                    }
                    const f32x4 cv = bb + w0 * p2 + w1 * p1 + w2 * x; const f32x4 up = acc[ai][1][m][n];
                    f32x4 o; o.x = gelu_tanh_f(cv.x) * up.x; o.y = gelu_tanh_f(cv.y) * up.y; o.z = gelu_tanh_f(cv.z) * up.z; o.w = gelu_tanh_f(cv.w) * up.w;
                    const bool skip = (ai == 0 && m == 0 && wr == 0 && frr < 2);
                    if (!skip) store4_bf16(ACT + (size_t)(row0 + ai * 128 + m * 16) * DFF + ch, o);
                }
            }
        }
    }
};
struct EpiMergeTile {
    static constexpr bool PERM = true;
    const u16* P; u16* MG;
    __device__ __forceinline__ void operator()(const f32x4 (&acc)[2][2][4][2], const pg8::Unit& u, int wr, int wc, int fr, int fq) const {
        int row0 = u.pm * 256 + wr * 64 + fr, col0 = u.pn * 256 + wc * 32 + 8 * fq;
        asm volatile("" : "+v"(row0), "+v"(col0));
        const int br = u.z;
#pragma unroll
        for (int ai = 0; ai < 2; ++ai)
#pragma unroll
            for (int m = 0; m < 4; ++m) { const int row = row0 + ai * 128 + m * 16;
#pragma unroll
                for (int bj = 0; bj < 2; ++bj) { const int col = col0 + bj * 128;
                    const u32x4 g = *(const u32x4*)(P + (size_t)row * NP + br * 1024 + col);
                    u32x4 old = (u32x4){0u, 0u, 0u, 0u}; if (br > 0) old = *(const u32x4*)(MG + (size_t)row * DM + col);
                    const f32x4 a0 = acc[ai][bj][m][0], a1 = acc[ai][bj][m][1];
                    u32x4 o;
                    o.x = pk2(__uint_as_float(old.x << 16) + __uint_as_float(g.x << 16) * a0.x, __uint_as_float(old.x & 0xffff0000u) + __uint_as_float(g.x & 0xffff0000u) * a0.y);
                    o.y = pk2(__uint_as_float(old.y << 16) + __uint_as_float(g.y << 16) * a0.z, __uint_as_float(old.y & 0xffff0000u) + __uint_as_float(g.y & 0xffff0000u) * a0.w);
                    o.z = pk2(__uint_as_float(old.z << 16) + __uint_as_float(g.z << 16) * a1.x, __uint_as_float(old.z & 0xffff0000u) + __uint_as_float(g.z & 0xffff0000u) * a1.y);
                    o.w = pk2(__uint_as_float(old.w << 16) + __uint_as_float(g.w << 16) * a1.z, __uint_as_float(old.w & 0xffff0000u) + __uint_as_float(g.w & 0xffff0000u) * a1.w);
                    *(u32x4*)(MG + (size_t)row * DM + col) = o; } }
    }
};
struct MergeSched {
    const char* P; const char* Wbr; int G, c;
    __device__ __forceinline__ bool next(int i, pg8::Unit& u) const {
        int pm, pn; if (!pg8::static_tile(i / 3, G, c, 64, 4, pm, pn)) return false; const int br = i % 3;
        const int ocol = br == 0 ? C_HI : (br == 1 ? C_GV : C_DQ);
        u.pm = pm; u.pn = pn; u.z = br; u.A = P + ((size_t)pm * 256 * NP + ocol) * 2; u.B = Wbr + ((size_t)br * 1024 * 512 + (size_t)pn * 256 * 512) * 2; return true;
    }
};
__device__ __forceinline__ void phase_p3b_naive(const Ctx& c, int rg0, int rg1) {
    const u16* P = c.P(); u16* MG = c.XN();
    const int ncg = DM / 64, nu = (rg1 - rg0) * ncg, fr = c.lane & 15, fq = c.lane >> 4;
    for (int u = c.gw; u < nu; u += c.NGW) {
        const int rg = rg0 + u / ncg, cgi = u % ncg, row = rg * 16 + fr;
        f32x4 tot[4];
#pragma unroll
        for (int i = 0; i < 4; ++i) tot[i] = (f32x4){0.f, 0.f, 0.f, 0.f};
#pragma unroll 1
        for (int br = 0; br < 3; ++br) {
            const int ocol = br == 0 ? C_HI : (br == 1 ? C_GV : C_DQ);
            f32x4 acc[4];
#pragma unroll
            for (int i = 0; i < 4; ++i) acc[i] = (f32x4){0.f, 0.f, 0.f, 0.f};
            wgemm16<4>(P + (size_t)row * NP + ocol + 8 * fq, true, (const u16*)(c.ws + W_BR) + (size_t)br * 1024 * 512 + (size_t)(cgi * 64 + fr) * 512 + 8 * fq, (size_t)16 * 512, 512, acc);
#pragma unroll
            for (int nt = 0; nt < 4; ++nt) { const u32x2 g = *(const u32x2*)(P + (size_t)row * NP + br * 1024 + cgi * 64 + nt * 16 + 4 * fq);
                f32x4 gv; gv.x = __uint_as_float(g.x << 16); gv.y = __uint_as_float(g.x & 0xffff0000u); gv.z = __uint_as_float(g.y << 16); gv.w = __uint_as_float(g.y & 0xffff0000u);
                tot[nt] = tot[nt] + gv * acc[nt]; }
        }
#pragma unroll
        for (int nt = 0; nt < 4; ++nt) store4_bf16(MG + (size_t)row * DM + cgi * 64 + nt * 16 + 4 * fq, tot[nt]);
    }
}
template <int MODE> __device__ __forceinline__ void phase_p5_naive(const Ctx& c, int l, int rg0, int rg1, int fb) {
    const u16* XN = c.XN(); u16* ACT = (u16*)(c.ws + WS_ARENA); const u16* Wgu = (const u16*)(c.ws + W_GU);
    const float* cw = c.pp->in[22] + (size_t)l * 3 * DFF; const float* cb = c.pp->in[23] + (size_t)l * DFF;
    const int ncg = DFF / 16, nu = (rg1 - rg0) * ncg, fr = c.lane & 15, fq = c.lane >> 4;
    if ((int)blockIdx.x < fb) return;
    const bf16x8 z = {0, 0, 0, 0, 0, 0, 0, 0};
    for (int u = c.gw - fb * 8; u < nu; u += c.NGW - fb * 8) {
        const int rg = rg0 + u / ncg, cgi = u % ncg, row = MODE == 0 ? rg * 16 + fr : 256 * (8 * rg + (fr >> 1)) + (fr & 1), r1 = prev_row(row), r2 = prev_row(r1);
        const int ch0 = cgi * 16, j = ch0 >> 7, cin = ch0 & 127;
        const u16* a0 = XN + (size_t)row * DM + 8 * fq; const u16* a1 = XN + (size_t)(r1 < 0 ? 0 : r1) * DM + 8 * fq; const u16* a2 = XN + (size_t)(r2 < 0 ? 0 : r2) * DM + 8 * fq;
        const u16* bg = Wgu + (size_t)(256 * j + cin + fr) * DM + 8 * fq; const u16* bu = bg + (size_t)128 * DM;
        f32x4 g0 = {0.f, 0.f, 0.f, 0.f}, g1 = g0, g2 = g0, up = g0;
#pragma unroll 8
        for (int k0 = 0; k0 < DM; k0 += 32) {
            const bf16x8 wg = *(const bf16x8*)(bg + k0), wu = *(const bf16x8*)(bu + k0), x0 = *(const bf16x8*)(a0 + k0);
            bf16x8 x1 = *(const bf16x8*)(a1 + k0), x2 = *(const bf16x8*)(a2 + k0); x1 = r1 >= 0 ? x1 : z; x2 = r2 >= 0 ? x2 : z;
            g0 = __builtin_amdgcn_mfma_f32_16x16x32_bf16(wg, x0, g0, 0, 0, 0); up = __builtin_amdgcn_mfma_f32_16x16x32_bf16(wu, x0, up, 0, 0, 0);
            g1 = __builtin_amdgcn_mfma_f32_16x16x32_bf16(wg, x1, g1, 0, 0, 0); g2 = __builtin_amdgcn_mfma_f32_16x16x32_bf16(wg, x2, g2, 0, 0, 0);
        }
        const int ch = ch0 + 4 * fq;
        const f32x4 w0 = *(const f32x4*)(cw + ch), w1 = *(const f32x4*)(cw + DFF + ch), w2 = *(const f32x4*)(cw + 2 * DFF + ch), bb = *(const f32x4*)(cb + ch);
        const f32x4 cv = bb + w0 * g2 + w1 * g1 + w2 * g0;
        f32x4 o; o.x = gelu_tanh_f(cv.x) * up.x; o.y = gelu_tanh_f(cv.y) * up.y; o.z = gelu_tanh_f(cv.z) * up.z; o.w = gelu_tanh_f(cv.w) * up.w;
        store4_bf16(ACT + (size_t)row * DFF + ch, o);
    }
}

template <int DK, bool HGRN> __device__ __forceinline__ void scan_naive_unit(const Ctx& c, int l, int b, int h) {
    u16* P = c.P();
    LAS float* sq = (LAS float*)c.lds; LAS float* sa = sq + 128; LAS float* sk = sa + 128; LAS float* red = sk + 128;
    const int qc = HGRN ? C_HQ + h * 128 : C_GQ + h * 64, gc = HGRN ? C_HF + h * 128 : C_GL + h * 64, kc = C_GK + h * 64;
    const int vc = (HGRN ? C_HI : C_GV) + h * 128, gatec = (HGRN ? C_HG : C_GG) + h * 128;
    const float* nw = (HGRN ? c.pp->in[5] : c.pp->in[8]) + l * 128;
    constexpr int DH = DK / 2;
    float S[DH];
#pragma unroll
    for (int d = 0; d < DH; ++d) S[d] = 0.f;
    const int t = c.tid, col = (t >> 1) & 127, half = t & 1; const float wn = nw[col];
    for (int p = 0; p < LSEQ; ++p) {
        const int row = row_of(b, p); const u16* pr = P + (size_t)row * NP;
        if (t < DK) { const float a = exp2f(h2f(pr[gc + t])); sq[t] = bf2f(pr[qc + t]); sa[t] = a; sk[t] = HGRN ? 1.f - a : bf2f(pr[kc + t]); }
        __syncthreads();
        float o = 0.f;
        if (t < 256) {
            const float v = bf2f(pr[vc + col]);
#pragma unroll
            for (int d = 0; d < DH; ++d) { const int dd = half * DH + d; S[d] = sa[dd] * S[d] + sk[dd] * v; o += sq[dd] * S[d]; }
        }
        o += __shfl_xor(o, 1);
        const float ss = wave_sum(half == 0 ? o * o : 0.f);
        if (c.lane == 0) red[c.wave] = ss;
        __syncthreads();
        if (t < 256 && half == 0) {
            const float tot = (red[0] + red[1]) + (red[2] + red[3]); const float r = rsqrtf(tot * (1.f / 128.f) + EPS);
            P[(size_t)row * NP + vc + col] = (u16)f2bf(o * r * wn * bf2f(pr[gatec + col]));
        }
        __syncthreads();
    }
}
__device__ __forceinline__ void attn_naive_unit(const Ctx& c, int l, int b, int h, int qb) {
    u16* P = c.P();
    LAS u16* Ks = (LAS u16*)c.lds;
    LAS u16* Vs = Ks + 64 * 128;
    const int i = c.tid >> 3, m = (c.tid >> 2) & 1, part = c.tid & 3, pos = qb * 64 + i; const bool valid = pos < LSEQ;
    const int row = row_of(b, valid ? pos : 0);
    float q[64];
    { const u16* qp = P + (size_t)row * NP + C_DQ + h * 128 + m * 64;
#pragma unroll
      for (int d = 0; d < 64; ++d) q[d] = bf2f(qp[d]); }
    const float slope2 = exp2f(-2.f * (float)(h + 1)) * LOG2E;
    float o[32], mx = -1e30f, ls = 0.f;
#pragma unroll
    for (int e = 0; e < 32; ++e) o[e] = 0.f;
    __syncthreads();
    for (int kt = 0; kt <= qb; ++kt) {
        for (int cc = c.tid; cc < 64 * 32; cc += 512) { const int jj = cc >> 5, ch = cc & 31; const int pj = kt * 64 + jj; const int rj = row_of(b, pj < LSEQ ? pj : 0);
            const u16* src = P + (size_t)rj * NP + (ch < 16 ? C_DK + h * 128 + ch * 8 : C_DV + h * 128 + (ch - 16) * 8);
            const u32x4 v = *(const u32x4*)src; LAS u16* dst = (ch < 16 ? Ks + jj * 128 + ch * 8 : Vs + jj * 128 + (ch - 16) * 8); *(LAS u32x4*)dst = v; }
        __syncthreads();
        for (int jj = 0; jj < 64; ++jj) {
            const int pj = kt * 64 + jj;
            if (valid && pj <= pos) {
                float s = 0.f;
#pragma unroll
                for (int d = 0; d < 64; ++d) s += q[d] * bf2f(Ks[jj * 128 + m * 64 + d]);
                s -= slope2 * (float)(pos - pj);
                const float n1 = fmaxf(mx, s), c1 = exp2f(mx - n1), p1 = exp2f(s - n1); mx = n1; ls = ls * c1 + p1;
#pragma unroll
                for (int e = 0; e < 32; ++e) { const float v = bf2f(Vs[jj * 128 + part * 32 + e]); o[e] = o[e] * c1 + p1 * v; }
            }
        }
        __syncthreads();
    }
    const float lam = ((const float*)(c.ws + WS_LAM))[l]; const float linit = 0.8f - 0.6f * expf(-0.3f * (float)l);
    float ss = 0.f; const float il = valid ? 1.f / ls : 0.f;
#pragma unroll
    for (int e = 0; e < 32; ++e) { const float on = o[e] * il; const float other = __shfl_xor(on, 4); o[e] = on - lam * other; ss += o[e] * o[e]; }
    ss += __shfl_xor(ss, 1); ss += __shfl_xor(ss, 2);
    const float r = rsqrtf(ss * (1.f / 128.f) + EPS) * (1.f - linit);
    if (valid && m == 0) { const float* sw = c.pp->in[13] + l * 128 + part * 32; u16* dst = P + (size_t)row * NP + C_DQ + h * 128 + part * 32;
#pragma unroll
        for (int e = 0; e < 32; ++e) dst[e] = (u16)f2bf(o[e] * r * sw[e]); }
}

namespace fa {
typedef float f32x16 __attribute__((ext_vector_type(16)));
typedef short v4i16_t __attribute__((ext_vector_type(4)));
constexpr int KSTR = 272, VSTR = 320, KBUF = 64 * KSTR, VBUF = 64 * VSTR, STAGE = KBUF + VBUF, XOFF = 0  , QSLOT = 141312, FLAGS = QSLOT + 64;
static_assert(3 * STAGE <= QSLOT && 65536 <= QSLOT && FLAGS + 64 <= LDS_BYTES - 256, "attention LDS map");
__device__ __forceinline__ constexpr int crowc(int r) { return (r & 3) + 8 * (r >> 2); }
__device__ __forceinline__ unsigned cvtpk(float lo, float hi) { typedef float f2 __attribute__((ext_vector_type(2))); typedef __bf16 b2 __attribute__((ext_vector_type(2))); f2 v = {lo, hi}; b2 b = __builtin_convertvector(v, b2); return __builtin_bit_cast(unsigned, b); }
template <bool DRY> __device__ __forceinline__ void attn_unit(const Ctx& c, int l, int b, int h, int qblk) {
    typedef __attribute__((address_space(1))) u16 gu16; typedef __attribute__((address_space(1))) u32x4 gu32x4; typedef __attribute__((address_space(1))) u32x2 gu32x2; typedef __attribute__((address_space(1))) bf16x8 gbf16x8;
    gu16* P = (gu16*)c.P();
    const int tid = c.tid, lane = tid & 63, wave = c.wave, m = wave >> 2, wq = wave & 3, q31 = lane & 31, hi = lane >> 5;
    const bool meta = qblk < 0;
    const int qrow0 = meta ? 0 : 128 * qblk + 32 * wq;
    const bool wave_active = !meta || wq == 0;
    const int qi = qrow0 + q31;
    const bool qvalid = !meta || qi < 16;
    const int qrow = meta ? MREAL + 16 * b + (qvalid ? qi : 0) : b * TS + qi;
    const int posq = meta ? (qvalid ? qi : 0) : 16 + qi;
    const float slope2 = exp2f(-2.f * (float)(h + 1)) * LOG2E;
    bf16x8 qf[4];
    { const gu16* qp = P + (size_t)qrow * NP + C_DQ + h * 128 + m * 64 + 8 * hi;
#pragma unroll
      for (int s = 0; s < 4; ++s) qf[s] = *(const gbf16x8*)(qp + 16 * s); }
    f32x16 O[4];
#pragma unroll
    for (int i = 0; i < 4; ++i)
#pragma unroll
        for (int r = 0; r < 16; ++r) O[i][r] = 0.f;
    float mrun = -1e30f, lsum = 0.f;
    const int nreal = meta ? 0 : 2 * qblk + 2, NT = nreal + 1;
    float qb;
    { float s1 = 0.f;
#pragma unroll
      for (int s = 0; s < 4; ++s)
#pragma unroll
          for (int e = 0; e < 8; ++e) s1 += fabsf(__uint_as_float(((unsigned)(unsigned short)qf[s][e]) << 16));
      s1 += __shfl_xor(s1, 32);
      qb = s1 * __uint_as_float(((const unsigned*)(c.ws + WS_KMAX))[4 * l + h]) * 1.01f; }
    struct TReg { u32x4 k[2], v[2]; };
    auto load_tile = [&](int it, TReg& R) {
        if (it > NT - 1) it = NT - 1;
        const bool mt = it >= nreal; const int kt = nreal - 1 - it;
#pragma unroll
        for (int i = 0; i < 2; ++i) { const int cidx = tid + 512 * i, row = cidx >> 4, ch = cidx & 15;
            const bool ok = !mt || row < 16; const int grow = mt ? MREAL + 16 * b + (ok ? row : 0) : b * TS + 64 * kt + row;
            const gu16* gp = P + (size_t)grow * NP + h * 128 + ch * 8;
            u32x4 kv = *(const gu32x4*)(gp + C_DK), vv = *(const gu32x4*)(gp + C_DV);
            if (!ok) { kv = (u32x4){0u, 0u, 0u, 0u}; vv = kv; }
            R.k[i] = kv; R.v[i] = vv; }
    };
    auto store_tile = [&](int buf, const TReg& R) {
#pragma unroll
        for (int i = 0; i < 2; ++i) { const int cidx = tid + 512 * i, row = cidx >> 4, ch = cidx & 15;
            *(LAS u32x4*)(c.lds + buf * STAGE + row * KSTR + ch * 16) = R.k[i];
            *(LAS u32x4*)(c.lds + buf * STAGE + KBUF + row * VSTR + ch * 16) = R.v[i]; }
    };
#define FA_BAR() do { asm volatile("s_waitcnt lgkmcnt(0)" ::: "memory"); __builtin_amdgcn_s_barrier(); asm volatile("" ::: "memory"); } while (0)
    volatile LAS int* flags = (volatile LAS int*)(c.lds + FLAGS);
    const int li = lane & 15, G = lane >> 4;
    auto compute = [&](int it, int cur) {
        const bool mt = it >= nreal; const int kt = nreal - 1 - it;
        const int tbase = mt ? 0 : 16 + 64 * kt;
        const bool skip = !wave_active || (!mt && 64 * kt > qrow0 + 31);
        if (!skip) {
            const LAS unsigned char* sb = c.lds + cur * STAGE;
            const bool need_mask = mt || (64 * kt + 63 > qrow0);
            f32x16 p0, p1;
#pragma unroll
            for (int r = 0; r < 16; ++r) { p0[r] = 0.f; p1[r] = 0.f; }
            { const LAS unsigned char* kb = sb + q31 * KSTR + (m * 64 + 8 * hi) * 2;
#pragma unroll
              for (int s = 0; s < 4; ++s) { const bf16x8 a0 = *(const LAS bf16x8*)(kb + s * 32); p0 = __builtin_amdgcn_mfma_f32_32x32x16_bf16(a0, qf[s], p0, 0, 0, 0); }
              if (!mt) {
#pragma unroll
                  for (int s = 0; s < 4; ++s) { const bf16x8 a1 = *(const LAS bf16x8*)(kb + 32 * KSTR + s * 32); p1 = __builtin_amdgcn_mfma_f32_32x32x16_bf16(a1, qf[s], p1, 0, 0, 0); } } }
            const float base0 = slope2 * (float)(tbase - posq + 4 * hi), base1 = base0 + slope2 * 32.f;
#pragma unroll
            for (int r = 0; r < 16; ++r) { const float t = slope2 * (float)crowc(r); p0[r] += base0 + t; p1[r] += base1 + t; }
            if (need_mask) {
                const int lim = min(posq - tbase, (mt ? 16 : 64) - 1) - 4 * hi;
#pragma unroll
                for (int r = 0; r < 16; ++r) { if (crowc(r) > lim) p0[r] = -1e30f; if (crowc(r) + 32 > lim) p1[r] = -1e30f; }
            }
            if (mt) {
#pragma unroll
                for (int r = 0; r < 16; ++r) p1[r] = -1e30f;
            }
            float mx = p0[0];
#pragma unroll
            for (int r = 1; r < 16; ++r) mx = fmaxf(mx, p0[r]);
#pragma unroll
            for (int r = 0; r < 16; ++r) mx = fmaxf(mx, p1[r]);
            mx = fmaxf(mx, __shfl_xor(mx, 32));
            if (__any(mx > mrun)) {
                const float mnew = fmaxf(mrun, mx), alpha = __builtin_amdgcn_exp2f(mrun - mnew); mrun = mnew; lsum *= alpha;
#pragma unroll
                for (int i = 0; i < 4; ++i)
#pragma unroll
                    for (int r = 0; r < 16; ++r) O[i][r] *= alpha;
            }
            float ps = 0.f;
#pragma unroll
            for (int r = 0; r < 16; ++r) { p0[r] = __builtin_amdgcn_exp2f(p0[r] - mrun); p1[r] = __builtin_amdgcn_exp2f(p1[r] - mrun); ps += p0[r] + p1[r]; }
            lsum += ps;
            bf16x8 pf[4];
#pragma unroll
            for (int s = 0; s < 4; ++s) { u32x4 w;
                if (s < 2) { w.x = cvtpk(p0[8 * s + 0], p0[8 * s + 1]); w.y = cvtpk(p0[8 * s + 2], p0[8 * s + 3]); w.z = cvtpk(p0[8 * s + 4], p0[8 * s + 5]); w.w = cvtpk(p0[8 * s + 6], p0[8 * s + 7]); }
                else { const int t = s - 2; w.x = cvtpk(p1[8 * t + 0], p1[8 * t + 1]); w.y = cvtpk(p1[8 * t + 2], p1[8 * t + 3]); w.z = cvtpk(p1[8 * t + 4], p1[8 * t + 5]); w.w = cvtpk(p1[8 * t + 6], p1[8 * t + 7]); }
                pf[s] = __builtin_bit_cast(bf16x8, w); }
            const LAS unsigned char* vb = sb + KBUF + (4 * (G >> 1) + (li >> 2)) * VSTR + (16 * (G & 1) + 4 * (li & 3)) * 2;
            const int nks = mt ? 2 : 4;
#pragma unroll
            for (int s = 0; s < 4; ++s) {
                if (s < nks) {
#pragma unroll
                    for (int blk = 0; blk < 4; ++blk) {
                        const v4i16_t t1 = __builtin_amdgcn_ds_read_tr16_b64_v4i16((LAS v4i16_t*)(vb + (16 * s) * VSTR + blk * 64));
                        const v4i16_t t2 = __builtin_amdgcn_ds_read_tr16_b64_v4i16((LAS v4i16_t*)(vb + (16 * s + 8) * VSTR + blk * 64));
                        const bf16x8 vf = {t1[0], t1[1], t1[2], t1[3], t2[0], t2[1], t2[2], t2[3]};
                        O[blk] = __builtin_amdgcn_mfma_f32_32x32x16_bf16(vf, pf[s], O[blk], 0, 0, 0);
                    }
                }
            }
        }
    };
    int it = 0, cur = 0;
    auto iter = [&](TReg& R1, TReg& R2) -> bool {
        if (it + 2 < NT) load_tile(it + 2, R2);
        compute(it, cur);
        const int nxt = cur == 2 ? 0 : cur + 1;
        if (it + 1 < NT) store_tile(nxt, R1);
        const int kt = nreal - 1 - it;
        bool wdone = false;
        if (it + 1 < nreal) { const int maxpos = 16 + 64 * (kt - 1) + 63; wdone = __all(!wave_active || (qb + slope2 * (float)(maxpos - posq) - mrun < -150.f)); }
        if (lane == 0) flags[(it & 1) * 8 + wave] = wdone ? 1 : 0;
        FA_BAR();
        bool jump = false;
        if (it + 1 < nreal) { int a = 1;
#pragma unroll
            for (int w = 0; w < 8; ++w) a &= flags[(it & 1) * 8 + w];
            jump = a != 0; }
        cur = nxt;
        if (jump) {
            load_tile(nreal, R2); const int st2 = cur == 2 ? 0 : cur + 1; store_tile(st2, R2); cur = st2; it = nreal;
            FA_BAR();
            compute(it, cur);
            FA_BAR();
            return false;
        }
        ++it;
        return it < NT;
    };
    TReg RA, RB;
    load_tile(0, RA); store_tile(0, RA);
    if (NT > 1) load_tile(1, RA);
    FA_BAR();
    for (;;) { if (!iter(RA, RB)) break; if (!iter(RB, RA)) break; }
    asm volatile("s_waitcnt vmcnt(0)" ::: "memory");
    FA_BAR();
#undef FA_BAR
    lsum += __shfl_xor(lsum, 32);
    const float inv = 1.f / lsum;
    LAS float* X = (LAS float*)(c.lds + XOFF);
    if (m == 1) {
#pragma unroll
        for (int i = 0; i < 4; ++i)
#pragma unroll
            for (int r = 0; r < 16; ++r) X[(wq * 64 + i * 16 + r) * 64 + lane] = O[i][r] * inv;
    }
    __syncthreads();
    if (m == 0) {
        const float lam = ((const float*)(c.ws + WS_LAM))[l]; const float linit = 0.8f - 0.6f * expf(-0.3f * (float)l);
        float ss = 0.f;
#pragma unroll
        for (int i = 0; i < 4; ++i)
#pragma unroll
            for (int r = 0; r < 16; ++r) { const float d = O[i][r] * inv - lam * X[(wq * 64 + i * 16 + r) * 64 + lane]; O[i][r] = d; ss += d * d; }
        ss += __shfl_xor(ss, 32);
        const float rn = rsqrtf(ss * (1.f / 128.f) + EPS) * (1.f - linit);
        if (qvalid && wave_active && (!DRY || ss < -1.f)) {
            const float* sw = c.pp->in[13] + l * 128; gu16* dst = P + (size_t)qrow * NP + C_DQ + h * 128;
#pragma unroll
            for (int i = 0; i < 4; ++i)
#pragma unroll
                for (int rq = 0; rq < 4; ++rq) { const int dv = 32 * i + 8 * rq + 4 * hi; const f32x4 w = *(const f32x4*)(sw + dv);
                    f32x4 o; o.x = O[i][4 * rq + 0] * rn * w.x; o.y = O[i][4 * rq + 1] * rn * w.y; o.z = O[i][4 * rq + 2] * rn * w.z; o.w = O[i][4 * rq + 3] * rn * w.w;
                    { u32x2 ow; ow.x = pk2(o.x, o.y); ow.y = pk2(o.z, o.w); *(gu32x2*)(dst + dv) = ow; } }
        }
    }
    __syncthreads();
}
}

namespace scan {
constexpr int NSS = LSEQ / 16;
constexpr int NSEG = 8;
constexpr int OBOFF = 61440, OBS = 132;
constexpr int KHS = 64;
template <int DK> struct Lay { static constexpr int RS = DK * 2 + 16, QH = 0, QT = QH + 16 * RS, KT = QT + 16 * RS, KHT = KT + 16 * RS, VT = KHT + DK * KHS, DC = VT + 128 * KHS, SIZE = DC + DK * 4; };
static_assert(2 * Lay<128>::SIZE <= OBOFF && OBOFF + 64 * OBS * 4 <= 131072 && (Lay<128>::SIZE % 16) == 0 && (Lay<64>::SIZE % 16) == 0, "scan LDS map");
constexpr size_t SD_SLOT = 65536, SD_OFF = WS_SCAN, DG_OFF = WS_SCAN + 8 * MiB;
struct Raw { u32x2 q, g, k, v; };
__device__ __forceinline__ int rowss(int b, int ss, int tok) { return ss == 0 ? MREAL + 16 * b + tok : b * TS + 16 * (ss - 1) + tok; }
template <int N> __device__ __forceinline__ float dpp_shr(float x) { return __builtin_bit_cast(float, __builtin_amdgcn_update_dpp(0, __builtin_bit_cast(int, x), 0x110 + N, 0xf, 0xf, true)); }
__device__ __forceinline__ float ex2(float x) { return __builtin_amdgcn_exp2f(x); }
__device__ __forceinline__ unsigned cvtpk(float lo, float hi) { typedef float f2 __attribute__((ext_vector_type(2))); typedef __bf16 b2 __attribute__((ext_vector_type(2))); f2 v = {lo, hi}; b2 b = __builtin_convertvector(v, b2); return __builtin_bit_cast(unsigned, b); }
template <int DK, bool HGRN, int MODE, bool DRY> __device__ __forceinline__ void stream(const Ctx& c, int l, int st, int b, int h, int seg) {
    typedef Lay<DK> LY;
    typedef __attribute__((address_space(1))) u16 gu16; typedef __attribute__((address_space(1))) u32x2 gu32x2; typedef __attribute__((address_space(1))) float gf32; typedef __attribute__((address_space(1))) f32x4 gf32x4;
    gu16* P = (gu16*)c.P();
    const int tid = c.tid, lane = tid & 63, wave = c.wave, i16 = lane & 15, g4 = lane >> 4;
    const int qc = HGRN ? C_HQ + h * 128 : C_GQ + h * 64, gc = HGRN ? C_HF + h * 128 : C_GL + h * 64, kc = C_GK + h * 64;
    const int vc = (HGRN ? C_HI : C_GV) + h * 128, gatec = (HGRN ? C_HG : C_GG) + h * 128;
    const float* nw = (HGRN ? c.pp->in[5] : c.pp->in[8]) + l * 128;
    const bool pact = wave < DK / 16;
    const int d0 = pact ? 16 * wave + 4 * g4 : 0;
    const int vtok = tid & 15, vdq = tid >> 4;
    const int ss_b = seg == 0 ? 0 : 64 * seg + 1, ss_e = 64 * seg + 65;
    gf32* SD = (gf32*)(c.ws + SD_OFF); gf32* DG = (gf32*)(c.ws + DG_OFF);
    unsigned* cnt = (unsigned*)(c.ws + WS_CTL) + 2048 + 64 * (l * 16 + st);
    float gsum[4] = {0.f, 0.f, 0.f, 0.f};
    auto load_raw = [&](int ss) -> Raw {
        Raw R; if (ss > NSS - 1) ss = NSS - 1;
        const gu16* pr = P + (size_t)rowss(b, ss, i16) * NP;
        R.q = MODE == 0 ? (u32x2){0u, 0u} : *(const gu32x2*)(pr + qc + d0); R.g = *(const gu32x2*)(pr + gc + d0); R.k = HGRN ? (u32x2){0u, 0u} : *(const gu32x2*)(pr + kc + d0);
        R.v = *(const gu32x2*)(P + (size_t)rowss(b, ss, vtok) * NP + vc + 4 * vdq);
        return R;
    };
    auto prep = [&](const Raw& R, int buf) {
        LAS unsigned char* B = c.lds + buf * LY::SIZE;
        if (pact) {
            float gg[4], q[4], k[4];
            gg[0] = h2f((u16)(R.g.x & 0xffffu)); gg[1] = h2f((u16)(R.g.x >> 16)); gg[2] = h2f((u16)(R.g.y & 0xffffu)); gg[3] = h2f((u16)(R.g.y >> 16));
            q[0] = __uint_as_float(R.q.x << 16); q[1] = __uint_as_float(R.q.x & 0xffff0000u); q[2] = __uint_as_float(R.q.y << 16); q[3] = __uint_as_float(R.q.y & 0xffff0000u);
            if (HGRN) {
#pragma unroll
                for (int e = 0; e < 4; ++e) k[e] = 1.f - ex2(gg[e]);
            } else { k[0] = __uint_as_float(R.k.x << 16); k[1] = __uint_as_float(R.k.x & 0xffff0000u); k[2] = __uint_as_float(R.k.y << 16); k[3] = __uint_as_float(R.k.y & 0xffff0000u); }
            float qh[4], qt[4], kt[4], kh[4], dl[4];
#pragma unroll
            for (int e = 0; e < 4; ++e) {
                float x = gg[e];
                x += dpp_shr<1>(x); x += dpp_shr<2>(x); x += dpp_shr<4>(x); x += dpp_shr<8>(x);
                const float gl = __shfl(x, lane | 15);
                kh[e] = k[e] * ex2(gl - x); dl[e] = ex2(gl); gsum[e] += gl;
                if (MODE == 1) { const float gmid = __shfl(x, (lane & 48) | 7); qh[e] = q[e] * ex2(x); qt[e] = q[e] * ex2(x - gmid); kt[e] = k[e] * ex2(gmid - x); }
            }
            if (MODE == 1) {
                u32x2 w;
                w.x = cvtpk(qh[0], qh[1]); w.y = cvtpk(qh[2], qh[3]); *(LAS u32x2*)(B + LY::QH + i16 * LY::RS + d0 * 2) = w;
                w.x = cvtpk(qt[0], qt[1]); w.y = cvtpk(qt[2], qt[3]); *(LAS u32x2*)(B + LY::QT + i16 * LY::RS + d0 * 2) = w;
                w.x = cvtpk(kt[0], kt[1]); w.y = cvtpk(kt[2], kt[3]); *(LAS u32x2*)(B + LY::KT + i16 * LY::RS + d0 * 2) = w;
            }
            { const unsigned k01 = cvtpk(kh[0], kh[1]), k23 = cvtpk(kh[2], kh[3]); LAS unsigned char* kp = B + LY::KHT + d0 * KHS + (i16 >> 2) * 16 + (i16 & 3) * 2;
              *(LAS u16*)(kp) = (u16)(k01 & 0xffffu); *(LAS u16*)(kp + KHS) = (u16)(k01 >> 16); *(LAS u16*)(kp + 2 * KHS) = (u16)(k23 & 0xffffu); *(LAS u16*)(kp + 3 * KHS) = (u16)(k23 >> 16); }
            if (i16 == 15) *(LAS f32x4*)(B + LY::DC + d0 * 4) = (f32x4){dl[0], dl[1], dl[2], dl[3]};
        }
        { const unsigned v0 = R.v.x, v1 = R.v.y; LAS unsigned char* vt = B + LY::VT + (4 * vdq) * KHS + (vtok >> 2) * 16 + (vtok & 3) * 2;
          *(LAS u16*)(vt) = (u16)(v0 & 0xffffu); *(LAS u16*)(vt + KHS) = (u16)(v0 >> 16); *(LAS u16*)(vt + 2 * KHS) = (u16)(v1 & 0xffffu); *(LAS u16*)(vt + 3 * KHS) = (u16)(v1 >> 16); }
    };
    f32x4 T[DK / 16];
#pragma unroll
    for (int r = 0; r < DK / 16; ++r) T[r] = (f32x4){0.f, 0.f, 0.f, 0.f};
    LAS float* OB = (LAS float*)(c.lds + OBOFF);
#define SC_BAR() do { asm volatile("s_waitcnt lgkmcnt(0)" ::: "memory"); __builtin_amdgcn_s_barrier(); asm volatile("" ::: "memory"); } while (0)
    for (int i = tid; i < 2 * (DK + 128) * 4; i += 512) { const int buf = i / ((DK + 128) * 4), j = i % ((DK + 128) * 4); *(LAS u32x2*)(c.lds + buf * LY::SIZE + LY::KHT + j * 16 + 8) = (u32x2){0u, 0u}; }
    if (MODE == 1 && seg > 0) {
        if (tid == 0) { unsigned sp = 0; while (__hip_atomic_load(cnt, __ATOMIC_RELAXED, __HIP_MEMORY_SCOPE_AGENT) < (unsigned)(NSEG - 1)) { __builtin_amdgcn_s_sleep(8); if (++sp > (1u << 22)) break; }
            __builtin_amdgcn_fence(__ATOMIC_ACQUIRE, "agent"); asm volatile("s_waitcnt vmcnt(0)" ::: "memory"); }
        __syncthreads();
#pragma unroll 1
        for (int s2 = 0; s2 < seg; ++s2) {
            const gf32* sd = SD + (size_t)(st * (NSEG - 1) + s2) * (SD_SLOT / 4); const gf32* dg = DG + (size_t)(st * NSEG + s2) * 128;
#pragma unroll
            for (int r = 0; r < DK / 16; ++r) { const f32x4 dec = *(const gf32x4*)(dg + 16 * r + 4 * g4);
#pragma unroll
                for (int e = 0; e < 4; ++e) T[r][e] = T[r][e] * dec[e] + sd[(size_t)(16 * r + 4 * g4 + e) * 128 + 16 * wave + i16]; }
        }
    }
    auto mfma_stage = [&](int ss) {
        const LAS unsigned char* B = c.lds + (ss & 1) * LY::SIZE;
        const bf16x8 vf = *(const LAS bf16x8*)(B + LY::VT + (16 * wave + i16) * KHS + 16 * g4);
        if (MODE == 1) {
            f32x4 o = (f32x4){0.f, 0.f, 0.f, 0.f};
#pragma unroll
            for (int s = 0; s < DK / 32; ++s) {
                const u32x2 alo = *(const LAS u32x2*)(B + LY::QH + i16 * LY::RS + (32 * s + 4 * g4) * 2), ahi = *(const LAS u32x2*)(B + LY::QH + i16 * LY::RS + (32 * s + 16 + 4 * g4) * 2);
                const u32x4 aw = {alo.x, alo.y, ahi.x, ahi.y};
                u32x4 bw; bw.x = cvtpk(T[2 * s][0], T[2 * s][1]); bw.y = cvtpk(T[2 * s][2], T[2 * s][3]); bw.z = cvtpk(T[2 * s + 1][0], T[2 * s + 1][1]); bw.w = cvtpk(T[2 * s + 1][2], T[2 * s + 1][3]);
                o = __builtin_amdgcn_mfma_f32_16x16x32_bf16(__builtin_bit_cast(bf16x8, aw), __builtin_bit_cast(bf16x8, bw), o, 0, 0, 0);
            }
            f32x4 at = (f32x4){0.f, 0.f, 0.f, 0.f};
#pragma unroll
            for (int s = 0; s < DK / 32; ++s) {
                const bf16x8 ka = *(const LAS bf16x8*)(B + LY::KT + i16 * LY::RS + (32 * s + 8 * g4) * 2), qa = *(const LAS bf16x8*)(B + LY::QT + i16 * LY::RS + (32 * s + 8 * g4) * 2);
                at = __builtin_amdgcn_mfma_f32_16x16x32_bf16(ka, qa, at, 0, 0, 0);
            }
#pragma unroll
            for (int r = 0; r < 4; ++r) if (4 * g4 + r > i16) at[r] = 0.f;
            const bf16x8 a16 = __builtin_bit_cast(bf16x8, (u32x4){cvtpk(at[0], at[1]), cvtpk(at[2], at[3]), 0u, 0u});
            o = __builtin_amdgcn_mfma_f32_16x16x32_bf16(a16, vf, o, 0, 0, 0);
            const int slot = ss == 0 ? 0 : ((ss - 1) & 3);
#pragma unroll
            for (int r = 0; r < 4; ++r) OB[(slot * 16 + 4 * g4 + r) * OBS + 16 * wave + i16] = o[r];
        }
#pragma unroll
        for (int r = 0; r < DK / 16; ++r) {
            const f32x4 dec = *(const LAS f32x4*)(B + LY::DC + (16 * r + 4 * g4) * 4);
            const bf16x8 kh = *(const LAS bf16x8*)(B + LY::KHT + (16 * r + i16) * KHS + 16 * g4);
            T[r] = __builtin_amdgcn_mfma_f32_16x16x32_bf16(kh, vf, T[r] * dec, 0, 0, 0);
        }
    };
    Raw RA, RB;
    const int ntok_part = tid >> 3, part = tid & 7;
    LAS float* NWL = (LAS float*)(c.lds + OBOFF + 64 * OBS * 4);
    if (MODE == 1 && tid < 128) NWL[tid] = nw[tid];
    auto step = [&](int ss, Raw& RX, const bool gend) {
        u32x2 gw[4]; const int ntok = ss == 0 ? 16 : 64; const int nrow = ss == 0 ? MREAL + 16 * b + (ntok_part & 15) : b * TS + 16 * (ss - 4) + ntok_part;
        if (MODE == 1 && gend) { const gu16* gp = P + (size_t)nrow * NP + gatec + 16 * part;
#pragma unroll
            for (int j = 0; j < 4; ++j) gw[j] = *(const gu32x2*)(gp + 4 * j); }
        if (wave < 4) { if (ss + 1 < ss_e) prep(RX, (ss + 1) & 1); RX = load_raw(ss + 3); mfma_stage(ss); }
        else          { mfma_stage(ss); if (ss + 1 < ss_e) prep(RX, (ss + 1) & 1); RX = load_raw(ss + 3); }
        SC_BAR();
        if (MODE == 1 && gend) {
            if (ntok_part < ntok && (!DRY || T[0][0] == 12345.678f)) {
                f32x4 ov[4]; float sq = 0.f;
#pragma unroll
                for (int j = 0; j < 4; ++j) { ov[j] = *(const LAS f32x4*)(OB + ntok_part * OBS + 16 * part + 4 * j); sq += (ov[j].x * ov[j].x + ov[j].y * ov[j].y) + (ov[j].z * ov[j].z + ov[j].w * ov[j].w); }
                sq += __shfl_xor(sq, 1); sq += __shfl_xor(sq, 2); sq += __shfl_xor(sq, 4);
                const float rn = rsqrtf(sq * (1.f / 128.f) + EPS);
                gu16* op = P + (size_t)nrow * NP + vc + 16 * part;
#pragma unroll
                for (int j = 0; j < 4; ++j) { const f32x4 w = *(const LAS f32x4*)(NWL + 16 * part + 4 * j);
                    u32x2 ow; ow.x = cvtpk(ov[j].x * rn * w.x * __uint_as_float(gw[j].x << 16), ov[j].y * rn * w.y * __uint_as_float(gw[j].x & 0xffff0000u));
                    ow.y = cvtpk(ov[j].z * rn * w.z * __uint_as_float(gw[j].y << 16), ov[j].w * rn * w.w * __uint_as_float(gw[j].y & 0xffff0000u));
                    *(gu32x2*)(op + 4 * j) = ow; }
            }
            SC_BAR();
        }
    };
    if (seg == 0) {
        { const Raw R0 = load_raw(0); prep(R0, 0); }
        RA = load_raw(1); RB = load_raw(2);
        SC_BAR();
        step(0, RA, true);
#pragma unroll 1
        for (int ss = 1; ss < ss_e; ss += 4) { step(ss, RB, false); step(ss + 1, RA, false); step(ss + 2, RB, false); step(ss + 3, RA, true); }
    } else {
        { const Raw R0 = load_raw(ss_b); prep(R0, ss_b & 1); }
        RA = load_raw(ss_b + 1); RB = load_raw(ss_b + 2);
        SC_BAR();
#pragma unroll 1
        for (int ss = ss_b; ss < ss_e; ss += 4) { step(ss, RA, false); step(ss + 1, RB, false); step(ss + 2, RA, false); step(ss + 3, RB, true); }
    }
    if (MODE == 0) {
        gf32* sd = SD + (size_t)(st * (NSEG - 1) + seg) * (SD_SLOT / 4);
#pragma unroll
        for (int r = 0; r < DK / 16; ++r)
#pragma unroll
            for (int e = 0; e < 4; ++e) sd[(size_t)(16 * r + 4 * g4 + e) * 128 + 16 * wave + i16] = T[r][e];
        if (pact && i16 == 15) *(gf32x4*)(DG + (size_t)(st * NSEG + seg) * 128 + d0) = (f32x4){ex2(gsum[0]), ex2(gsum[1]), ex2(gsum[2]), ex2(gsum[3])};
        asm volatile("s_waitcnt vmcnt(0)" ::: "memory");
        __syncthreads();
        if (tid == 0) { __builtin_amdgcn_fence(__ATOMIC_RELEASE, "agent"); asm volatile("s_waitcnt vmcnt(0)" ::: "memory"); __hip_atomic_fetch_add(cnt, 1u, __ATOMIC_RELAXED, __HIP_MEMORY_SCOPE_AGENT); }
    }
    asm volatile("s_waitcnt vmcnt(0)" ::: "memory");
#undef SC_BAR
}
}
#ifndef PROBE_MODE
#define PROBE_MODE 0
#endif
template <bool DRY, bool SCANS, bool ATTN> __device__ __forceinline__ void phase_p2(const Ctx& c0, int l0, int qsel) {
    constexpr int NA = 16 * (scan::NSEG - 1), NB_ = 16 * scan::NSEG, NH = 144, NATT = NB * 4 * 64 + NB * 4, NU = NA + NATT + NB_;
    for (;;) {
        const Ctx c = fresh(c0); int l = l0; asm volatile("" : "+s"(l));
        unsigned* qctr = (unsigned*)(c.ws + WS_CTL) + 1024 + 64 * (2 * l + qsel);
        volatile LAS int* slot = (volatile LAS int*)(c.lds + fa::QSLOT);
        if (c.tid == 0) *slot = (int)atomicAdd(qctr, 1u);
        __syncthreads();
        const int u = *slot;
        __syncthreads();
        if (u >= NU) break;
        int a = -1;
        if (u < NA) {
            if (SCANS) { const int st = u / (scan::NSEG - 1), seg = u % (scan::NSEG - 1), b = (st >> 2) & 1, h = st & 3;
                if (st < 8) scan::stream<128, true, 0, DRY>(c, l, st, b, h, seg); else scan::stream<64, false, 0, DRY>(c, l, st, b, h, seg); }
        } else if (u < NA + NH) a = u - NA;
        else if (u < NA + NH + NB_) {
            if (SCANS) { const int v = u - NA - NH, st = v / scan::NSEG, seg = v % scan::NSEG, b = (st >> 2) & 1, h = st & 3;
                if (st < 8) scan::stream<128, true, 1, DRY>(c, l, st, b, h, seg); else scan::stream<64, false, 1, DRY>(c, l, st, b, h, seg); }
        } else a = u - NA - NB_;
        if (ATTN && a >= 0) {
            if (a < 512) { int qblk, b, h;
                if (a < 256) { qblk = 63 - (a >> 2); b = (a >> 1) & 1; h = 2 + (a & 1); }
                else { const int a2 = a - 256; h = a2 < 128 ? 1 : 0; const int a3 = a2 & 127; qblk = 63 - (a3 >> 1); b = a3 & 1; }
                fa::attn_unit<DRY>(c, l, b, h, qblk); }
            else { const int bh = a - 512; fa::attn_unit<DRY>(c, l, bh >> 2, bh & 3, -1); }
        }
        __syncthreads();
    }
}
__device__ __forceinline__ void phase_p2_naive(const Ctx& c, int l) {
    constexpr int NQB = (LSEQ + 63) / 64;
    const int nattn = NB * 4 * NQB, ntot = nattn + 16;
    for (int u = blockIdx.x; u < ntot; u += c.G) {
        if (u < 16) { const int mixer = u >> 3, b = (u >> 2) & 1, h = u & 3; if (mixer == 0) scan_naive_unit<128, true>(c, l, b, h); else scan_naive_unit<64, false>(c, l, b, h); }
        else { const int a = u - 16; const int qb = NQB - 1 - a / 8, bh = a % 8; attn_naive_unit(c, l, bh >> 2, bh & 3, qb); }
        __syncthreads();
    }
}

__global__ void __launch_bounds__(512, 2) mega_fwd(Params prm) {
    extern __shared__ __attribute__((aligned(16))) unsigned char lds_raw[];
    cg::grid_group grid = cg::this_grid();
    Ctx c0;
    c0.pp = &prm; c0.out = prm.out; c0.ws = prm.ws;
    c0.tid = threadIdx.x; c0.lane = c0.tid & 63; c0.wave = __builtin_amdgcn_readfirstlane(c0.tid >> 6); c0.G = gridDim.x; c0.gw = blockIdx.x * 8 + c0.wave; c0.NGW = c0.G * 8;
    c0.lds = (LAS unsigned char*)lds_raw;
    constexpr int RG_ALL = MROWS / 16, RG_REAL = MREAL / 16;
    for (int u = c0.tid; u < 64; u += 512) ((LAS unsigned*)(c0.lds + LDS_BYTES - 256))[u] = 0u;
    __syncthreads();
    const XcdBarrier xbar = xcd_barrier_post((unsigned*)(c0.ws + WS_CTL) + 4096, (volatile LAS unsigned*)(c0.lds + LDS_BYTES - 256));
#define GSYNC() xcd_barrier(xbar)

    { const Ctx c = fresh(c0);
      prep_misc(c);
      prep_weights_A(c, 0);
      for (int r = c.gw; r < MROWS; r += c.NGW) {
          const float* src = r < MREAL ? c.pp->in[0] + (size_t)r * DM : c.pp->in[1] + (size_t)((r - MREAL) & 15) * DM;
          row_pass(src, c.hrow(r), nullptr, nullptr, c.pp->in[3], c.XN() + (size_t)r * DM, c.lane);
      } }
    grid.sync();
#pragma unroll 1
    for (int l = 0; l < DEPTH; ++l) {
        for (int rep = 0; rep < ((PROBE_MODE == 3) ? 2 : 1); ++rep) {
        { const Ctx c = fresh(c0); const float* LBl = (const float*)(c.ws + WS_LB) + l * 512; const float* gb = c.pp->in[7] + l * 256;
          pg8::PlainSched S{(const char*)c.XN(), (const char*)(c.ws + W_1T), (size_t)256 * DM * 2, (size_t)256 * DM * 2, NP / 256, c.G, (int)blockIdx.x};
          EpiP1Tile et{c.P(), LBl, gb, (unsigned*)(c.ws + WS_KMAX) + 4 * l}; pg8::gemm_phase<EpiP1Tile, pg8::PlainSched, true>(c.lds, DM, DM, DM, S, et); }
        { const Ctx c = fresh(c0); const float* LBl = (const float*)(c.ws + WS_LB) + l * 512; const float* gb = c.pp->in[7] + l * 256;
          EpiP1 e{c.P(), LBl, gb, (unsigned*)(c.ws + WS_KMAX) + 4 * l}; phase_ngemm(c, c.XN(), DM, RG_REAL, RG_ALL, (const u16*)(c.ws + W_1T), DM, NP, e, c.G == 256 ? 64 : 0); }
        GSYNC(); }
#if PROBE_MODE == 1
        { const Ctx c = fresh(c0); phase_p2<true, false, true>(c, l, 1); }
        GSYNC();
#elif PROBE_MODE == 2
        { const Ctx c = fresh(c0); phase_p2<true, true, false>(c, l, 1); }
        GSYNC();
#endif
        { const Ctx c = fresh(c0); phase_p2<false, true, true>(c, l, 0); }
        GSYNC();
        for (int rep = 0; rep < ((PROBE_MODE == 4) ? 2 : 1); ++rep) {
        { const Ctx c = fresh(c0);
          pg8::PlainSched S{(const char*)c.XN(), (const char*)(c.ws + W_MT), (size_t)256 * DM * 2, (size_t)256 * DM * 2, 3072 / 256, c.G, (int)blockIdx.x};
          pg8::EpiGran<EpiSig, true> et{EpiSig{c.P()}}; pg8::gemm_phase<pg8::EpiGran<EpiSig, true>, pg8::PlainSched, true>(c.lds, DM, DM, DM, S, et); }
        { const Ctx c = fresh(c0); EpiSig e{c.P()}; phase_ngemm(c, c.XN(), DM, RG_REAL, RG_ALL, (const u16*)(c.ws + W_MT), DM, 3072, e); }
        GSYNC();
        { const Ctx c = fresh(c0); MergeSched S{(const char*)c.P(), (const char*)(c.ws + W_BR), c.G, (int)blockIdx.x};
          EpiMergeTile et{c.P(), c.XN()}; pg8::gemm_phase<EpiMergeTile, MergeSched, true>(c.lds, NP, 512, 512, S, et); }
        { const Ctx c = fresh(c0); phase_p3b_naive(c, RG_REAL, RG_ALL); }
        GSYNC();
        { const Ctx c = fresh(c0);
          pg8::PlainSched S{(const char*)c.XN(), (const char*)(c.ws + W_OUT), (size_t)256 * DM * 2, (size_t)256 * DM * 2, DM / 256, c.G, (int)blockIdx.x};
          EpiF32 e{(float*)(c.ws + WS_ARENA)}; pg8::EpiGran<EpiF32, false> et{e}; pg8::gemm_phase<pg8::EpiGran<EpiF32, false>, pg8::PlainSched, false>(c.lds, DM, DM, DM, S, et); }
        { const Ctx c = fresh(c0); EpiF32 e{(float*)(c.ws + WS_ARENA)}; phase_ngemm(c, c.XN(), DM, RG_REAL, RG_ALL, (const u16*)(c.ws + W_OUT), DM, DM, e); }
        GSYNC(); }
        { const Ctx c = fresh(c0);
          for (int r = c.gw; r < MROWS; r += c.NGW)
              row_pass(c.hrow(r), c.hrow(r), (const float*)(c.ws + WS_ARENA) + (size_t)r * DM, c.pp->in[18] + l * DM, c.pp->in[19] + l * DM, c.XN() + (size_t)r * DM, c.lane);
          prep_weights_B(c, l); }
        GSYNC();
        for (int rep = 0; rep < ((PROBE_MODE == 5) ? 2 : 1); ++rep) {
        { const Ctx c = fresh(c0);
          pg8::PlainSched S{(const char*)c.XN(), (const char*)(c.ws + W_GU), (size_t)256 * DM * 2, (size_t)256 * DM * 2, 5632 / 256, c.G, (int)blockIdx.x};
          EpiConvTile et{(u16*)(c.ws + WS_ARENA), c.pp->in[22] + (size_t)l * 3 * DFF, c.pp->in[23] + (size_t)l * DFF, (LAS float*)(c.lds + 131072)};
          pg8::gemm_phase<EpiConvTile, pg8::PlainSched, true>(c.lds, DM, DM, DM, S, et); }
        { const Ctx c = fresh(c0); phase_p5_naive<0>(c, l, RG_REAL, RG_ALL, c.G == 256 ? 128 : 0); }
        { const Ctx c = fresh(c0); phase_p5_naive<1>(c, l, 0, 8, c.G == 256 ? 128 : 0); }
        GSYNC();
        { const Ctx c = fresh(c0);
          pg8::PlainSched S{(const char*)(c.ws + WS_ARENA), (const char*)(c.ws + W_DN), (size_t)256 * DFF * 2, (size_t)256 * DFF * 2, DM / 256, c.G, (int)blockIdx.x};
          EpiF32 e{(float*)(c.ws + WS_ARENA + AR_Z)}; pg8::EpiGran<EpiF32, false> et{e}; pg8::gemm_phase<pg8::EpiGran<EpiF32, false>, pg8::PlainSched, false>(c.lds, DFF, DFF, DFF, S, et); }
        { const Ctx c = fresh(c0); EpiF32 e{(float*)(c.ws + WS_ARENA + AR_Z)}; phase_ngemm(c, (const u16*)(c.ws + WS_ARENA), DFF, RG_REAL, RG_ALL, (const u16*)(c.ws + W_DN), DFF, DM, e); }
        GSYNC(); }
        { const Ctx c = fresh(c0);
          for (int r = c.gw; r < MROWS; r += c.NGW)
              row_pass(c.hrow(r), c.hrow(r), (const float*)(c.ws + WS_ARENA + AR_Z) + (size_t)r * DM, c.pp->in[25] + l * DM, l + 1 < DEPTH ? c.pp->in[3] + (l + 1) * DM : nullptr, l + 1 < DEPTH ? c.XN() + (size_t)r * DM : nullptr, c.lane);
          if (l + 1 < DEPTH) prep_weights_A(c, l + 1); }
        if (l + 1 < DEPTH) GSYNC();
    }
}

extern "C" void kernel_launch(void* const* d_in, const int* in_sizes, int n_in, void* d_out, int out_size, void* d_ws, size_t ws_size, hipStream_t stream) {
    static int grid = 0;
    if (grid == 0) {
        if (n_in != 26 || out_size != MREAL * DM || ws_size < WS_END) { fprintf(stderr, "kernel_launch: unexpected shapes n_in %d out %d ws %zu (need %zu)\n", n_in, out_size, ws_size, (size_t)WS_END); grid = -1; return; }
        int dev = 0, cus = 0, per_cu = 0;
        hipGetDevice(&dev); hipDeviceGetAttribute(&cus, hipDeviceAttributeMultiprocessorCount, dev);
        hipFuncSetAttribute((const void*)mega_fwd, hipFuncAttributeMaxDynamicSharedMemorySize, LDS_BYTES);
        hipOccupancyMaxActiveBlocksPerMultiprocessor(&per_cu, (const void*)mega_fwd, 512, LDS_BYTES);
        if (per_cu < 1) { fprintf(stderr, "kernel_launch: occupancy query says %d\n", per_cu); per_cu = 1; }
        grid = cus * 1;
        (void)hipGetLastError();
    }
    if (grid < 0) return;
    hipMemsetAsync((char*)d_ws + WS_CTL, 0, 64 * 1024, stream);
    Params p{};
    for (int i = 0; i < 26; ++i) p.in[i] = (const float*)d_in[i];
    p.out = (float*)d_out; p.ws = (unsigned char*)d_ws;
    void* args[] = {&p};
    hipError_t e = hipLaunchCooperativeKernel((const void*)mega_fwd, dim3(grid), dim3(512), args, LDS_BYTES, stream);
    if (e != hipSuccess) fprintf(stderr, "cooperative launch failed: %s (grid %d)\n", hipGetErrorString(e), grid);
}
```
